# Optimizing an MI355X kernel written in HIP

```python
import jax, jax.numpy as jnp
from jax import lax
import numpy as np

D_MODEL = 1024
BATCH = 8
SEQ = 4096
DEPTH = 2

N_EVEN = (DEPTH + 1) // 2
N_ODD = DEPTH // 2
RG_WIDTH = D_MODEL // 2
RG_BLOCKS = 8
RG_BLOCK_DIM = RG_WIDTH // RG_BLOCKS
CONV_WIDTH = 4
CONV_LEFT = 2
CONV_RIGHT = 1
RG_C = 8.0
HG_WIDTH = D_MODEL // 2
HG_HEADS = 4
HG_HEAD_DIM = HG_WIDTH // HG_HEADS
GLA_HEADS = 4
GLA_KEY_DIM = D_MODEL // 2
GLA_VALUE_DIM = D_MODEL
GLA_HEAD_K = GLA_KEY_DIM // GLA_HEADS
GLA_HEAD_V = GLA_VALUE_DIM // GLA_HEADS
GLA_LOWRANK = 16
GLA_GATE_NORMALIZER = 16.0
D_FF = 4 * D_MODEL
CHUNK = 64
EPS = 1e-6
AB_IN_SIZES = (RG_WIDTH, RG_WIDTH, HG_WIDTH, HG_WIDTH, HG_WIDTH, HG_WIDTH, HG_WIDTH)
AB_IN_WIDTH = 2 * RG_WIDTH + 5 * HG_WIDTH
AB_OUT_WIDTH = RG_WIDTH + HG_WIDTH
GLA_IN_SIZES = (GLA_KEY_DIM, GLA_KEY_DIM, GLA_VALUE_DIM, GLA_VALUE_DIM, GLA_LOWRANK, GLA_LOWRANK)
GLA_IN_WIDTH = 2 * GLA_KEY_DIM + 2 * GLA_VALUE_DIM + 2 * GLA_LOWRANK

kernel_name = "bidir_hybrid_rglru_hgrn2_gla_trunk"


def split_cols(t, sizes):
    offsets = []
    acc = 0
    for s in sizes[:-1]:
        acc += s
        offsets.append(acc)
    return jnp.split(t, offsets, axis=-1)


def rmsnorm(x, gain):
    x32 = x.astype(jnp.float32)
    y = x32 * lax.rsqrt(jnp.mean(x32 * x32, axis=-1, keepdims=True) + EPS)
    return (y * gain.astype(jnp.float32)).astype(x.dtype)


def to_heads(t, n_heads):
    b, s, w = t.shape
    return t.reshape(b, s, n_heads, w // n_heads).transpose(0, 2, 1, 3)


def head_rmsnorm(o, gain):
    b, h, s, d = o.shape
    o32 = o.astype(jnp.float32)
    o32 = o32 * lax.rsqrt(jnp.mean(o32 * o32, axis=-1, keepdims=True) + EPS)
    o32 = o32.transpose(0, 2, 1, 3).reshape(b, s, h * d)
    return (o32 * gain.astype(jnp.float32)).astype(o.dtype)


def chunk_gated_linear_attn(q, k, v, logf):
    b, h, s, dk = q.shape
    dv = v.shape[-1]
    n = s // CHUNK
    qc = q.reshape(b, h, n, CHUNK, dk)
    kc = k.reshape(b, h, n, CHUNK, dk)
    vc = v.reshape(b, h, n, CHUNK, dv)
    cum = jnp.cumsum(logf.astype(jnp.float32).reshape(b, h, n, CHUNK, dk), axis=3)
    ref = cum[:, :, :, CHUNK // 2:CHUNK // 2 + 1, :]
    last = cum[:, :, :, CHUNK - 1:, :]
    q_in = qc * jnp.exp(cum - ref)
    k_in = kc * jnp.exp(ref - cum)
    scores = jnp.einsum('bhnld,bhnmd->bhnlm', q_in, k_in)
    mask = jnp.tril(jnp.ones((CHUNK, CHUNK), dtype=bool))
    scores = jnp.where(mask, scores, 0.0)
    o_intra = jnp.einsum('bhnlm,bhnmv->bhnlv', scores, vc)
    k_state = kc * jnp.exp(last - cum)
    upd = jnp.einsum('bhnld,bhnlv->bhndv', k_state, vc)
    decay = jnp.exp(last[:, :, :, 0, :])

    def step(state, inp):
        d, u = inp
        return d[..., None] * state + u, state

    init = jnp.zeros((b, h, dk, dv), dtype=upd.dtype)
    _, s_prev = lax.scan(step, init, (jnp.moveaxis(decay, 2, 0), jnp.moveaxis(upd, 2, 0)))
    o_inter = jnp.einsum('bhnld,nbhdv->bhnlv', qc * jnp.exp(cum), s_prev)
    return (o_intra + o_inter).reshape(b, h, s, dv)


def bidir_gated_linear_attn(q, k_f, k_b, v, logf_f, logf_b):
    rev = lambda t: jnp.flip(t, axis=2)
    fwd = chunk_gated_linear_attn(q, k_f, v, logf_f)
    bwd = rev(chunk_gated_linear_attn(rev(q), rev(k_b), rev(v), rev(logf_b)))
    return fwd + bwd


def linear_scan_combine(left, right):
    a1, b1 = left
    a2, b2 = right
    return a1 * a2, a2 * b1 + b2


def rglru_branch(xa, ga, conv_w, conv_b, w_a, b_a, w_x, b_x, lam):
    bsz, s, _ = xa.shape
    xc = lax.conv_general_dilated(
        xa, conv_w[:, None, :], window_strides=(1,), padding=[(CONV_LEFT, CONV_RIGHT)],
        dimension_numbers=('NWC', 'WIO', 'NWC'), feature_group_count=RG_WIDTH) + conv_b
    xb = xc.reshape(bsz, s, RG_BLOCKS, RG_BLOCK_DIM)
    r = jax.nn.sigmoid(jnp.einsum('bsgi,dgij->dbsgj', xb, w_a).reshape(2, bsz, s, RG_WIDTH)
                       + b_a[:, None, None, :])
    i = jax.nn.sigmoid(jnp.einsum('bsgi,dgij->dbsgj', xb, w_x).reshape(2, bsz, s, RG_WIDTH)
                       + b_x[:, None, None, :])
    log_a = -RG_C * r * jax.nn.softplus(-lam)[:, None, None, :]
    a = jnp.exp(log_a)
    u = jnp.sqrt(-jnp.expm1(2.0 * log_a)) * (i * xc[None])
    _, h_f = lax.associative_scan(linear_scan_combine, (a[0], u[0]), axis=1)
    _, h_b = lax.associative_scan(linear_scan_combine, (a[1], u[1]), axis=1, reverse=True)
    return (h_f + h_b) * jax.nn.gelu(ga)


def hgrn2_branch(q, f_f, f_b, iv, g, lb, norm_gain):
    qh = to_heads(jax.nn.silu(q), HG_HEADS)
    vh = to_heads(iv, HG_HEADS)

    def gates(fpre):
        fpre32 = fpre.astype(jnp.float32)
        logf = jnp.log(lb + (1.0 - lb) * jax.nn.sigmoid(fpre32))
        k = (1.0 - lb) * jax.nn.sigmoid(-fpre32)
        return to_heads(k, HG_HEADS), to_heads(logf, HG_HEADS)

    k_f, logf_f = gates(f_f)
    k_b, logf_b = gates(f_b)
    o = bidir_gated_linear_attn(qh, k_f, k_b, vh, logf_f, logf_b)
    return head_rmsnorm(o, norm_gain) * jax.nn.silu(g)


def gla_mixer(y, w_in, w_gate_up, b_gate, norm_gain):
    proj = y @ w_in
    q, k, v, r, lr_f, lr_b = split_cols(proj, GLA_IN_SIZES)
    qh = to_heads(q, GLA_HEADS) * (GLA_HEAD_K ** -0.5)
    kh = to_heads(k, GLA_HEADS)
    vh = to_heads(v, GLA_HEADS)

    def log_gate(lr, w_up, bias):
        z = jnp.einsum('bsr,rk->bsk', lr, w_up) + bias
        return to_heads(jax.nn.log_sigmoid(z.astype(jnp.float32)) / GLA_GATE_NORMALIZER, GLA_HEADS)

    logf_f = log_gate(lr_f, w_gate_up[0], b_gate[0])
    logf_b = log_gate(lr_b, w_gate_up[1], b_gate[1])
    o = bidir_gated_linear_attn(qh, kh, kh, vh, logf_f, logf_b)
    return head_rmsnorm(o, norm_gain) * jax.nn.silu(r)


def setup_inputs(seed: int = 0) -> dict:
    key = jax.random.key(seed)
    ks = jax.random.split(key, 24)
    nrm = lambda k, shape, scale: jax.random.normal(k, shape, jnp.float32) * scale
    u = jax.random.uniform(ks[10], (N_EVEN, 2, RG_WIDTH), jnp.float32, minval=0.9, maxval=0.999)
    p = u ** (1.0 / RG_C)
    rg_lambda = jnp.log(p) - jnp.log1p(-p)
    return {
        "x": nrm(ks[0], (BATCH, SEQ, D_MODEL), 1.0),
        "norm_mix": 1.0 + nrm(ks[1], (DEPTH, D_MODEL), 0.02),
        "norm_mlp": 1.0 + nrm(ks[2], (DEPTH, D_MODEL), 0.02),
        "norm_final": 1.0 + nrm(ks[3], (D_MODEL,), 0.02),
        "mlp_w1": nrm(ks[4], (DEPTH, D_MODEL, D_FF), D_MODEL ** -0.5),
        "mlp_w2": nrm(ks[5], (DEPTH, D_FF, D_MODEL), D_FF ** -0.5),
        "ab_w_in": nrm(ks[6], (N_EVEN, D_MODEL, AB_IN_WIDTH), D_MODEL ** -0.5),
        "ab_w_out": nrm(ks[7], (N_EVEN, AB_OUT_WIDTH, D_MODEL), AB_OUT_WIDTH ** -0.5),
        "rg_conv_w": nrm(ks[8], (N_EVEN, CONV_WIDTH, RG_WIDTH), CONV_WIDTH ** -0.5),
        "rg_conv_b": nrm(ks[9], (N_EVEN, RG_WIDTH), 0.01),
        "rg_w_a": nrm(ks[11], (N_EVEN, 2, RG_BLOCKS, RG_BLOCK_DIM, RG_BLOCK_DIM), RG_BLOCK_DIM ** -0.5),
        "rg_b_a": nrm(ks[12], (N_EVEN, 2, RG_WIDTH), 0.01),
        "rg_w_x": nrm(ks[13], (N_EVEN, 2, RG_BLOCKS, RG_BLOCK_DIM, RG_BLOCK_DIM), RG_BLOCK_DIM ** -0.5),
        "rg_b_x": nrm(ks[14], (N_EVEN, 2, RG_WIDTH), 0.01),
        "rg_lambda": rg_lambda,
        "hg_lb_logits": nrm(ks[15], (N_EVEN + 1, HG_WIDTH), 0.1),
        "hg_norm": 1.0 + nrm(ks[16], (N_EVEN, HG_WIDTH), 0.02),
        "gla_w_in": nrm(ks[17], (N_ODD, D_MODEL, GLA_IN_WIDTH), D_MODEL ** -0.5),
        "gla_w_out": nrm(ks[18], (N_ODD, GLA_VALUE_DIM, D_MODEL), GLA_VALUE_DIM ** -0.5),
        "gla_w_gate_up": nrm(ks[19], (N_ODD, 2, GLA_LOWRANK, GLA_KEY_DIM), GLA_LOWRANK ** -0.5),
        "gla_b_gate": nrm(ks[20], (N_ODD, 2, GLA_KEY_DIM), 0.01),
        "gla_norm": 1.0 + nrm(ks[21], (N_ODD, GLA_VALUE_DIM), 0.02),
    }


def reference(x, norm_mix, norm_mlp, norm_final, mlp_w1, mlp_w2, ab_w_in, ab_w_out,
              rg_conv_w, rg_conv_b, rg_w_a, rg_b_a, rg_w_x, rg_b_x, rg_lambda,
              hg_lb_logits, hg_norm, gla_w_in, gla_w_out, gla_w_gate_up, gla_b_gate, gla_norm):
    lbs = jnp.cumsum(jax.nn.softmax(hg_lb_logits.astype(jnp.float32), axis=0), axis=0)
    h = x
    for layer in range(DEPTH):
        j = layer // 2
        y = rmsnorm(h, norm_mix[layer])
        if layer % 2 == 0:
            proj = y @ ab_w_in[j]
            xa, ga, q, f_f, f_b, iv, g = split_cols(proj, AB_IN_SIZES)
            ya = rglru_branch(xa, ga, rg_conv_w[j], rg_conv_b[j], rg_w_a[j], rg_b_a[j],
                              rg_w_x[j], rg_b_x[j], rg_lambda[j])
            yb = hgrn2_branch(q, f_f, f_b, iv, g, lbs[j], hg_norm[j])
            mix = jnp.concatenate([ya, yb], axis=-1) @ ab_w_out[j]
        else:
            mix = gla_mixer(y, gla_w_in[j], gla_w_gate_up[j], gla_b_gate[j], gla_norm[j]) @ gla_w_out[j]
        h = h + mix
        y = rmsnorm(h, norm_mlp[layer])
        h = h + jnp.square(jax.nn.relu(y @ mlp_w1[layer])) @ mlp_w2[layer]
    return rmsnorm(h, norm_final)
```

```cpp
#include <hip/hip_runtime.h>
#include <hip/hip_cooperative_groups.h>
#include <cstdio>
namespace cg = cooperative_groups;

#ifndef MULTI
#define MULTI 0
#endif

#define PG8_LAS __attribute__((address_space(3)))
typedef unsigned short bf16_t;
typedef short bf16x8 __attribute__((ext_vector_type(8)));
typedef float f32x4 __attribute__((ext_vector_type(4)));
typedef unsigned u32x4 __attribute__((ext_vector_type(4)));
typedef unsigned u32x2 __attribute__((ext_vector_type(2)));

__device__ __forceinline__ int ltid() { int t = threadIdx.x; asm volatile("" : "+v"(t)); return t; }
namespace pg8 {
constexpr int BM = 256, BK = 64, HALF = 128, HTB = HALF * BK * 2, STAGE_BYTES = 8 * HTB, NXCD = 8, WGM = 4;
__host__ __device__ __forceinline__ int lds_byte(int r, int c) { const int st = (r >> 4) * 2 + (c >> 5), rr = r & 15, cc = c & 31, ob = rr * 64 + cc * 2; return st * 1024 + (ob ^ (((ob >> 9) & 1) << 5)); }
__host__ __device__ __forceinline__ void stage_rc(int b, int& R, int& C) { const int st = b / 1024, sb = b % 1024, swz = sb ^ (((sb >> 9) & 1) << 5); R = (st >> 1) * 16 + swz / 64; C = (st & 1) * 32 + (swz % 64) / 2; }
__host__ __device__ __forceinline__ int perm32(int rho) { const int n = rho >> 4, i = rho & 15; return 8 * (i >> 2) + 4 * n + (i & 3); }
struct Unit { int pm, pn; };
struct Gemm { const bf16_t* A; const bf16_t* Bt; int M, N, K; };
struct StaticOrder {
    int nM, nN, nwg, G, c;
    __host__ __device__ void init(int M, int N, int G_, int c_) { nM = M / BM; nN = N / BM; nwg = nM * nN; G = G_; c = c_; }
    __host__ __device__ bool next(int i, Unit& u) const {
        const long L = (long)i * G + c; if (L >= nwg) return false;
        int wgid = (int)L; { const int q = nwg / NXCD, r = nwg % NXCD, xcd = wgid % NXCD, off = wgid / NXCD; wgid = (xcd < r ? xcd * (q + 1) : r * (q + 1) + (xcd - r) * q) + off; }
        const int nig = WGM * nN, gid = wgid / nig, fm = gid * WGM, gsz = (nM - fm) < WGM ? (nM - fm) : WGM;
        u.pm = fm + ((wgid % nig) % gsz); u.pn = (wgid % nig) / gsz; return true;
    }
    __device__ __forceinline__ void a_ready(const Unit&) const {}
    __device__ __forceinline__ void done(const Unit&) const {}
};
typedef __bf16 bf16x2_t __attribute__((ext_vector_type(2)));
typedef float f32x2_t __attribute__((ext_vector_type(2)));
__device__ __forceinline__ unsigned cvt_pk_bf16(float lo, float hi) { f32x2_t v = {lo, hi}; bf16x2_t r = __builtin_convertvector(v, bf16x2_t); return __builtin_bit_cast(unsigned, r); }

template <class Epi, class Sched>
__device__ __forceinline__ void gemm_phase(PG8_LAS unsigned char* lds, const Gemm g, const Sched& S, const Epi& E) {
    const int tid = ltid(), wid = __builtin_amdgcn_readfirstlane(tid >> 6), lane = tid & 63, wr = wid >> 2, wc = wid & 3, fr = lane & 15, fq = lane >> 4;
    const int K = g.K, nt = K / BK;
    unsigned voffA[2], voffB[2];
#pragma unroll
    for (int i = 0; i < 2; ++i) { int R, C; stage_rc(tid * 16 + i * 8192, R, C); const int Rb = Epi::PERM ? ((R & ~31) + perm32(R & 31)) : R;
        voffA[i] = (unsigned)(R * K + C) * 2u; voffB[i] = (unsigned)(Rb * K + C) * 2u; }
    const size_t kstep = (size_t)(BK * 2);
    const size_t hstep = (size_t)HALF * K * 2;
    const size_t tstep = 2 * hstep;
    const unsigned ldsw = (unsigned)wid * 1024u;
    const int aoff = lds_byte(wr * 64 + fr, fq * 8), boff = lds_byte(wc * 32 + fr, fq * 8);
#define PG8_SA(b, h) (((b) * 2 + (h)) * HTB)
#define PG8_SB(b, h) ((4 + (b) * 2 + (h)) * HTB)
#define PG8_STAGE(bufoff, gbase, voff) do { _Pragma("unroll") for (int _i = 0; _i < 2; ++_i) \
        __builtin_amdgcn_global_load_lds((const unsigned*)((const char*)(gbase) + (voff)[_i]), (PG8_LAS unsigned*)(lds + (bufoff) + ldsw + _i * 8192), 16, 0, 0); } while (0)
#define PG8_LDA(dst, b, h) do { _Pragma("unroll") for (int m = 0; m < 4; ++m) _Pragma("unroll") for (int k = 0; k < 2; ++k) dst[m][k] = *(const PG8_LAS bf16x8*)(lds + PG8_SA(b, h) + aoff + m * 2048 + k * 1024); } while (0)
#define PG8_LDB(dst, b, h) do { _Pragma("unroll") for (int n = 0; n < 2; ++n) _Pragma("unroll") for (int k = 0; k < 2; ++k) dst[n][k] = *(const PG8_LAS bf16x8*)(lds + PG8_SB(b, h) + boff + n * 2048 + k * 1024); } while (0)
#define PG8_MMA(ai, bj, At, Bt) do { __builtin_amdgcn_s_setprio(1); _Pragma("unroll") for (int m = 0; m < 4; ++m) _Pragma("unroll") for (int n = 0; n < 2; ++n) _Pragma("unroll") for (int k = 0; k < 2; ++k) \
        acc[ai][bj][m][n] = __builtin_amdgcn_mfma_f32_16x16x32_bf16(Bt[n][k], At[m][k], acc[ai][bj][m][n], 0, 0, 0); __builtin_amdgcn_s_setprio(0); } while (0)
#define PG8_WAIT_V(n) asm volatile("s_waitcnt vmcnt(" #n ")" ::: "memory")
#define PG8_WAIT_L(n) asm volatile("s_waitcnt lgkmcnt(" #n ")" ::: "memory")
#define PG8_BAR __builtin_amdgcn_s_barrier()
#define PG8_SCHED __builtin_amdgcn_sched_barrier(0)
    Unit cur, nxt; int ui = 0;
    if (!S.next(0, cur)) return;
    f32x4 acc[2][2][4][2];
#pragma unroll
    for (int a = 0; a < 2; ++a)
#pragma unroll
        for (int b = 0; b < 2; ++b)
#pragma unroll
            for (int m = 0; m < 4; ++m)
#pragma unroll
                for (int n = 0; n < 2; ++n) acc[a][b][m][n] = (f32x4){0.f, 0.f, 0.f, 0.f};
    bf16x8 At[4][2], B0[2][2], B1[2][2];
    const char* cA = (const char*)g.A + (size_t)cur.pm * tstep; const char* cB = (const char*)g.Bt + (size_t)cur.pn * tstep;
    S.a_ready(cur);
    PG8_STAGE(PG8_SB(0, 0), cB, voffB); PG8_STAGE(PG8_SA(0, 0), cA, voffA); PG8_STAGE(PG8_SB(0, 1), cB + hstep, voffB); PG8_STAGE(PG8_SA(0, 1), cA + hstep, voffA);
    if (wr == 1) PG8_BAR;
    PG8_WAIT_V(4); PG8_BAR;
    PG8_STAGE(PG8_SB(1, 0), cB + kstep, voffB); PG8_STAGE(PG8_SA(1, 0), cA + kstep, voffA); PG8_STAGE(PG8_SB(1, 1), cB + hstep + kstep, voffB);
    PG8_WAIT_V(6); PG8_BAR;
    for (;;) {
        const bool has_next = S.next(ui + 1, nxt);
        const char* nA = has_next ? (const char*)g.A + (size_t)nxt.pm * tstep : cA; const char* nB = has_next ? (const char*)g.Bt + (size_t)nxt.pn * tstep : cB;
        for (int t = 0; t < nt; t += 2) {
            const bool last = (t == nt - 2);
            const char* a1 = cA + (size_t)(t + 1) * kstep;
            const char* a2 = last ? nA : cA + (size_t)(t + 2) * kstep; const char* b2 = last ? nB : cB + (size_t)(t + 2) * kstep;
            const char* a3 = a2 + kstep; const char* b3 = b2 + kstep;
            if (last && has_next) S.a_ready(nxt);
            PG8_LDB(B0, 0, 0); PG8_SCHED; PG8_LDA(At, 0, 0); PG8_STAGE(PG8_SA(1, 1), a1 + hstep, voffA);
            PG8_WAIT_L(8); PG8_BAR; PG8_WAIT_L(0); PG8_MMA(0, 0, At, B0); PG8_BAR; PG8_SCHED;
            PG8_LDB(B1, 0, 1); PG8_STAGE(PG8_SB(0, 0), b2, voffB);
            PG8_BAR; PG8_WAIT_L(0); PG8_MMA(0, 1, At, B1); PG8_BAR;
            PG8_LDA(At, 0, 1); PG8_STAGE(PG8_SA(0, 0), a2, voffA);
            PG8_BAR; PG8_WAIT_L(0); PG8_MMA(1, 0, At, B0); PG8_BAR; PG8_SCHED;
            PG8_STAGE(PG8_SB(0, 1), b2 + hstep, voffB);
            PG8_WAIT_V(6); PG8_BAR; PG8_MMA(1, 1, At, B1); PG8_BAR;
            PG8_LDB(B0, 1, 0); PG8_SCHED; PG8_LDA(At, 1, 0); PG8_STAGE(PG8_SA(0, 1), a2 + hstep, voffA);
            PG8_WAIT_L(8); PG8_BAR; PG8_WAIT_L(0); PG8_MMA(0, 0, At, B0); PG8_BAR; PG8_SCHED;
            PG8_LDB(B1, 1, 1); PG8_STAGE(PG8_SB(1, 0), b3, voffB);
            PG8_BAR; PG8_WAIT_L(0); PG8_MMA(0, 1, At, B1); PG8_BAR;
            PG8_LDA(At, 1, 1); PG8_STAGE(PG8_SA(1, 0), a3, voffA);
            PG8_BAR; PG8_WAIT_L(0); PG8_MMA(1, 0, At, B0); PG8_BAR; PG8_SCHED;
            PG8_STAGE(PG8_SB(1, 1), b3 + hstep, voffB);
            PG8_WAIT_V(6); PG8_BAR; PG8_MMA(1, 1, At, B1); PG8_BAR;
        }
        if constexpr (!Epi::AFTER_DRAIN) { E(acc, cur, wr, wc, fr, fq); S.done(cur); }
        if (!has_next) break;
#pragma unroll
        for (int a = 0; a < 2; ++a)
#pragma unroll
            for (int b = 0; b < 2; ++b)
#pragma unroll
                for (int m = 0; m < 4; ++m)
#pragma unroll
                    for (int n = 0; n < 2; ++n) acc[a][b][m][n] = (f32x4){0.f, 0.f, 0.f, 0.f};
        cur = nxt; cA = nA; cB = nB; ++ui;
    }
    PG8_WAIT_V(0);
    if (wr == 0) PG8_BAR;
    PG8_BAR;
    if constexpr (Epi::AFTER_DRAIN) { E.fused(acc, cur, wr, wc, fr, fq, lds, wid, lane); S.done(cur); }
#undef PG8_SA
#undef PG8_SB
#undef PG8_STAGE
#undef PG8_LDA
#undef PG8_LDB
#undef PG8_MMA
#undef PG8_WAIT_V
#undef PG8_WAIT_L
#undef PG8_BAR
#undef PG8_SCHED
}
}
using pg8::cvt_pk_bf16;

constexpr int MTOK = 32768, DM = 1024, SEQ = 4096, NB = 8, NCH = 64;
constexpr int N_AB = 3584, N_GLA = 3328  , N_GLA_SRC = 3104, DFF = 4096;
constexpr float EPS = 1e-6f;
constexpr size_t WO_ABIN = 0, WO_ABOUT = WO_ABIN + (size_t)N_AB * 1024, WO_W1_0 = WO_ABOUT + 1024 * 1024, WO_W2_0 = WO_W1_0 + 4096 * 1024,
                 WO_GLAIN = WO_W2_0 + 4096 * 1024, WO_GLAOUT = WO_GLAIN + (size_t)N_GLA * 1024, WO_W1_1 = WO_GLAOUT + 1024 * 1024, WO_W2_1 = WO_W1_1 + 4096 * 1024,
                 WO_END = WO_W2_1 + 4096 * 1024;
constexpr size_t MiB = 1048576;
constexpr size_t WS_W = 0, WS_MISC = 50 * MiB, WS_R1 = 58 * MiB, WS_A = 122 * MiB, WS_ST = WS_A + 224 * MiB, WS_HB = WS_A + 288 * MiB, WS_STG = WS_A + 208 * MiB, WS_SS = 510 * MiB, WS_END = 512 * MiB;
static_assert(WO_END * 2 <= 50 * MiB, "weights region");
constexpr size_t MO_SUMSQ = 0, MO_LBV = 655360, MO_SPL = 657408, MO_RGW = 1 * MiB, MO_RGA = 2 * MiB, MO_RGH = 4 * MiB, MO_DECAY = 6 * MiB, MO_WUPT = 786432, MO_BAR = 851968;

typedef unsigned long long u64;
constexpr float SS_SCALE = 16777216.0f, SS_INV = 1.0f / (16777216.0f * 1024.0f);
struct Params {
    const float* in[22];
    float* out;
    unsigned char* ws;
};

__device__ __forceinline__ Params load_params() {
#if defined(__HIP_DEVICE_COMPILE__)
    auto q = __builtin_amdgcn_kernarg_segment_ptr();
    asm volatile("" : "+s"(q));
    return *(const __attribute__((address_space(4))) Params*)q;
#else
    return Params{};
#endif
}
__device__ __forceinline__ float bf2f(bf16_t b) { return __uint_as_float(((unsigned)b) << 16); }
__device__ __forceinline__ bf16_t f2bf(float f) { unsigned u = __float_as_uint(f); u += 0x7FFFu + ((u >> 16) & 1u); return (bf16_t)(u >> 16); }
__device__ __forceinline__ float frcp(float x) { return __builtin_amdgcn_rcpf(x); }
__device__ __forceinline__ float fexp(float x) { return __builtin_amdgcn_exp2f(x * 1.4426950408889634f); }
__device__ __forceinline__ float flog(float x) { return __builtin_amdgcn_logf(x) * 0.6931471805599453f; }
__device__ __forceinline__ float sigmoidf_(float x) { return frcp(1.0f + fexp(-x)); }
__device__ __forceinline__ void unpack8(const u32x4 v, float (&f)[8]) {
#pragma unroll
    for (int i = 0; i < 4; ++i) { f[2 * i] = __uint_as_float(v[i] << 16); f[2 * i + 1] = __uint_as_float(v[i] & 0xffff0000u); }
}
__device__ __forceinline__ u32x4 pack8(const float (&f)[8]) { u32x4 r;
#pragma unroll
    for (int i = 0; i < 4; ++i) r[i] = cvt_pk_bf16(f[2 * i], f[2 * i + 1]);
    return r; }

__device__ __forceinline__ bf16_t* gla_state(const Params& p, int chain) {
    unsigned char* base = chain < 45 ? p.ws + WS_STG + (size_t)chain * (4 * MiB)
                        : chain < 61 ? (unsigned char*)p.out + 64 * MiB + (size_t)(chain - 45) * (4 * MiB)
                        : p.ws + WS_W + (size_t)(chain - 61) * (4 * MiB);
    return (bf16_t*)base;
}
template <int ACT> struct EpiScale {
    static constexpr bool PERM = true, AFTER_DRAIN = false;
    bf16_t* O; int ldc; const u64* sumsq;
    __device__ __forceinline__ void operator()(const f32x4 (&acc)[2][2][4][2], const pg8::Unit& u, int wr, int wc, int fr, int fq) const {
        const int row0 = u.pm * 256 + wr * 64 + fr, col0 = u.pn * 256 + wc * 32 + 8 * fq;
        float rs[2][4];
#pragma unroll
        for (int ai = 0; ai < 2; ++ai)
#pragma unroll
            for (int m = 0; m < 4; ++m) rs[ai][m] = (float)sumsq[row0 + ai * 128 + m * 16];
#pragma unroll
        for (int ai = 0; ai < 2; ++ai)
#pragma unroll
            for (int m = 0; m < 4; ++m) rs[ai][m] = rsqrtf(rs[ai][m] * SS_INV + EPS);
#pragma unroll
        for (int ai = 0; ai < 2; ++ai)
#pragma unroll
            for (int m = 0; m < 4; ++m) {
                const int row = row0 + ai * 128 + m * 16;
                bf16_t* rowp = O + (size_t)row * ldc + col0;
#pragma unroll
                for (int bj = 0; bj < 2; ++bj) {
                    f32x4 v0 = acc[ai][bj][m][0] * rs[ai][m], v1 = acc[ai][bj][m][1] * rs[ai][m];
                    if (ACT == 1) {
#pragma unroll
                        for (int e = 0; e < 4; ++e) { float a = fmaxf(v0[e], 0.f), b = fmaxf(v1[e], 0.f); v0[e] = a * a; v1[e] = b * b; }
                    }
                    u32x4 pk; pk[0] = cvt_pk_bf16(v0[0], v0[1]); pk[1] = cvt_pk_bf16(v0[2], v0[3]); pk[2] = cvt_pk_bf16(v1[0], v1[1]); pk[3] = cvt_pk_bf16(v1[2], v1[3]);
                    *(u32x4*)(rowp + bj * 128) = pk;
                }
            }
    }
};
template <bool XIN> struct EpiResid {
    static constexpr bool PERM = true, AFTER_DRAIN = false;
    const float* Xin; bf16_t* H; u64* sumsq;
    __device__ __forceinline__ void operator()(const f32x4 (&acc)[2][2][4][2], const pg8::Unit& u, int wr, int wc, int fr, int fq) const {
        const int row0 = u.pm * 256 + wr * 64 + fr, col0 = u.pn * 256 + wc * 32 + 8 * fq;
#pragma unroll
        for (int ai = 0; ai < 2; ++ai) {
            f32x4 hx[4][2][2]; u32x4 hb[4][2];
#pragma unroll
            for (int m = 0; m < 4; ++m)
#pragma unroll
                for (int bj = 0; bj < 2; ++bj) { const size_t ro = (size_t)(row0 + ai * 128 + m * 16) * 1024 + col0 + bj * 128;
                    if (XIN) { hx[m][bj][0] = *(const f32x4*)(Xin + ro); hx[m][bj][1] = *(const f32x4*)(Xin + ro + 4); } else hb[m][bj] = *(const u32x4*)(H + ro); }
            __builtin_amdgcn_sched_barrier(0);
#pragma unroll
            for (int m = 0; m < 4; ++m) {
                const int row = row0 + ai * 128 + m * 16;
                const size_t ro = (size_t)row * 1024 + col0;
                float ss = 0.f;
#pragma unroll
                for (int bj = 0; bj < 2; ++bj) {
                    f32x4 h0, h1;
                    if (XIN) { h0 = hx[m][bj][0]; h1 = hx[m][bj][1]; } else { float t[8]; unpack8(hb[m][bj], t); h0 = (f32x4){t[0], t[1], t[2], t[3]}; h1 = (f32x4){t[4], t[5], t[6], t[7]}; }
                    const f32x4 v0 = acc[ai][bj][m][0] + h0, v1 = acc[ai][bj][m][1] + h1;
                    u32x4 pk; pk[0] = cvt_pk_bf16(v0[0], v0[1]); pk[1] = cvt_pk_bf16(v0[2], v0[3]); pk[2] = cvt_pk_bf16(v1[0], v1[1]); pk[3] = cvt_pk_bf16(v1[2], v1[3]);
                    *(u32x4*)(H + ro + bj * 128) = pk;
#pragma unroll
                    for (int e = 0; e < 4; ++e) ss += v0[e] * v0[e] + v1[e] * v1[e];
                }
                ss += __shfl_xor(ss, 16); ss += __shfl_xor(ss, 32);
                if (fq == 0) (void)__hip_atomic_fetch_add(sumsq + row, (u64)(ss * SS_SCALE), __ATOMIC_RELAXED, __HIP_MEMORY_SCOPE_AGENT);
            }
            __builtin_amdgcn_sched_barrier(0);
        }
    }
};
template <class Epi> __device__ __forceinline__ void run_gemm(PG8_LAS unsigned char* lds, const bf16_t* A, const bf16_t* Bt, int N, int K, const Epi& E) {
    pg8::Gemm g; g.A = A; g.Bt = Bt; g.M = MTOK; g.N = N; g.K = K;
    pg8::StaticOrder S; S.init(MTOK, N, (int)gridDim.x, (int)blockIdx.x);
    pg8::gemm_phase<Epi, pg8::StaticOrder>(lds, g, S, E);
}

template <int MT, int NT, bool SWA, bool SWB, int K, class PA, class PB>
__device__ __forceinline__ void mma_tiles(f32x4 (&acc)[MT][NT], PA A, int lda, int m0, PB B, int ldb, int n0, int fr, int fq) {
#pragma unroll
    for (int k0 = 0; k0 < K; k0 += 32) {
        bf16x8 a[MT], b[NT];
#pragma unroll
        for (int mt = 0; mt < MT; ++mt) { const int row = m0 + mt * 16 + fr; int kb = (k0 >> 3) + fq; if (SWA) kb ^= (row >> 3) & 7; a[mt] = *(const bf16x8*)(A + row * lda + kb * 8); }
#pragma unroll
        for (int nt = 0; nt < NT; ++nt) { const int row = n0 + nt * 16 + fr; int kb = (k0 >> 3) + fq; if (SWB) kb ^= (row >> 3) & 7; b[nt] = *(const bf16x8*)(B + row * ldb + kb * 8); }
#pragma unroll
        for (int mt = 0; mt < MT; ++mt)
#pragma unroll
            for (int nt = 0; nt < NT; ++nt) acc[mt][nt] = __builtin_amdgcn_mfma_f32_16x16x32_bf16(b[nt], a[mt], acc[mt][nt], 0, 0, 0);
    }
}
typedef PG8_LAS float* lds_f32p;
typedef PG8_LAS bf16_t* lds_bf16p;

__device__ __forceinline__ void transpose_tile(const float* src, bf16_t* dst, const float* scale, int K, int Nsrc, int k0, int n0, lds_f32p T, int tid) {
    { const int r = tid >> 3, c = (tid & 7) * 8;
      f32x4 v0 = {0.f, 0.f, 0.f, 0.f}, v1 = v0;
      if (n0 + c < Nsrc) { const float* sp = src + (size_t)(k0 + r) * Nsrc + n0 + c; v0 = *(const f32x4*)sp; v1 = *(const f32x4*)(sp + 4); }
      const float sc = scale ? scale[k0 + r] : 1.0f;
#pragma unroll
      for (int e = 0; e < 4; ++e) { T[r * 65 + c + e] = v0[e] * sc; T[r * 65 + c + 4 + e] = v1[e] * sc; } }
    __syncthreads();
    { const int n = tid >> 3, kk = (tid & 7) * 8; float f[8];
#pragma unroll
      for (int e = 0; e < 8; ++e) f[e] = T[(kk + e) * 65 + n];
      *(u32x4*)(dst + (size_t)(n0 + n) * K + k0 + kk) = pack8(f); }
    __syncthreads();
}
__device__ void phase_prep(const Params& p, PG8_LAS unsigned char* lds) {
    const int tid = ltid(), lane = tid & 63, wid = tid >> 6;
    u64* sumsq = (u64*)(p.ws + WS_SS);
    bf16_t* xb = (bf16_t*)(p.ws + WS_R1);
    for (int row = blockIdx.x * 8 + wid; row < MTOK; row += gridDim.x * 8) {
        const float* xr = p.in[0] + (size_t)row * 1024; float ss = 0.f;
#pragma unroll
        for (int i = 0; i < 4; ++i) { const f32x4 v = *(const f32x4*)(xr + i * 256 + lane * 4); ss += v[0] * v[0] + v[1] * v[1] + v[2] * v[2] + v[3] * v[3];
            u32x2 pk; pk[0] = cvt_pk_bf16(v[0], v[1]); pk[1] = cvt_pk_bf16(v[2], v[3]); *(u32x2*)(xb + (size_t)row * 1024 + i * 256 + lane * 4) = pk; }
#pragma unroll
        for (int o = 32; o >= 1; o >>= 1) ss += __shfl_xor(ss, o);
        if (lane == 0) sumsq[row] = (u64)(ss * SS_SCALE);
    }
    const int gtid = blockIdx.x * 512 + tid, gstride = gridDim.x * 512;
    for (int i = gtid; i < 4 * MTOK; i += gstride) sumsq[MTOK + i] = 0ull;
    { bf16_t* rgw = (bf16_t*)(p.ws + WS_MISC + MO_RGW);
      for (int i = gtid; i < 131072; i += gstride) { const int mat = i >> 15, kind = mat >> 1, dir = mat & 1, g = (i >> 12) & 7, j = (i >> 6) & 63, ii = i & 63;
          const float* s = kind ? p.in[12] : p.in[10]; rgw[i] = f2bf(s[((dir * 8 + g) * 64 + ii) * 64 + j]); } }
    { bf16_t* wupt = (bf16_t*)(p.ws + WS_MISC + MO_WUPT);
      for (int i = gtid; i < 16384; i += gstride) { const int dir = i >> 13, d = (i >> 4) & 511, r = i & 15; wupt[i] = f2bf(p.in[19][(size_t)(dir * 16 + r) * 512 + d]); } }
    { float* lbv = (float*)(p.ws + WS_MISC + MO_LBV); float* spl = (float*)(p.ws + WS_MISC + MO_SPL);
      for (int i = gtid; i < 512; i += gstride) { const float l0 = p.in[15][i], l1 = p.in[15][512 + i]; lbv[i] = 1.0f / (1.0f + expf(l1 - l0)); }
      for (int i = gtid; i < 1024; i += gstride) { const float lam = p.in[14][i]; spl[i] = fmaxf(-lam, 0.f) + log1pf(expf(-fabsf(lam))); } }
    bf16_t* W = (bf16_t*)(p.ws + WS_W);
    lds_f32p T = (lds_f32p)lds;
    struct TD { const float* src; bf16_t* dst; const float* scale; int K, Nsrc, k0, n0; };
    auto desc = [&](int tile) { TD d; d.scale = nullptr; d.K = 1024; int Npad, base;
        if (tile < 896) { base = 0; d.src = p.in[6]; d.dst = W + WO_ABIN; d.scale = p.in[1]; d.Nsrc = Npad = 3584; }
        else if (tile < 1152) { base = 896; d.src = p.in[7]; d.dst = W + WO_ABOUT; d.Nsrc = Npad = 1024; }
        else if (tile < 2176) { base = 1152; d.src = p.in[4]; d.dst = W + WO_W1_0; d.scale = p.in[2]; d.Nsrc = Npad = 4096; }
        else if (tile < 3200) { base = 2176; d.src = p.in[5]; d.dst = W + WO_W2_0; d.K = 4096; d.Nsrc = Npad = 1024; }
        else if (tile < 4032) { base = 3200; d.src = p.in[17]; d.dst = W + WO_GLAIN; d.scale = p.in[1] + 1024; d.Nsrc = N_GLA_SRC; Npad = N_GLA; }
        else if (tile < 4288) { base = 4032; d.src = p.in[18]; d.dst = W + WO_GLAOUT; d.Nsrc = Npad = 1024; }
        else if (tile < 5312) { base = 4288; d.src = p.in[4] + (size_t)1024 * 4096; d.dst = W + WO_W1_1; d.scale = p.in[2] + 1024; d.Nsrc = Npad = 4096; }
        else { base = 5312; d.src = p.in[5] + (size_t)4096 * 1024; d.dst = W + WO_W2_1; d.K = 4096; d.Nsrc = Npad = 1024; }
        const int local = tile - base, ntn = Npad >> 6, kti = local / ntn, nti = local - kti * ntn; d.k0 = kti * 64; d.n0 = nti * 64; return d; };
    const int r = tid >> 3, c = (tid & 7) * 8;
    auto tload = [&](const TD& d, f32x4& v0, f32x4& v1, float& sc) { v0 = (f32x4){0.f, 0.f, 0.f, 0.f}; v1 = v0;
        if (d.n0 + c < d.Nsrc) { const float* sp = d.src + (size_t)(d.k0 + r) * d.Nsrc + d.n0 + c; v0 = *(const f32x4*)sp; v1 = *(const f32x4*)(sp + 4); }
        sc = d.scale ? d.scale[d.k0 + r] : 1.0f; };
    int tile = blockIdx.x, buf = 0; TD cur = desc(tile < 6336 ? tile : 0); f32x4 v0, v1; float sc;
    if (tile < 6336) tload(cur, v0, v1, sc);
    for (; tile < 6336; tile += gridDim.x, buf ^= 1) {
        const int nt_ = tile + gridDim.x; TD nxt = desc(nt_ < 6336 ? nt_ : 0); f32x4 n0v = v0, n1v = v1; float nsc = sc;
        if (nt_ < 6336) tload(nxt, n0v, n1v, nsc);
        lds_f32p Tb = T + buf * (64 * 65);
#pragma unroll
        for (int e = 0; e < 4; ++e) { Tb[r * 65 + c + e] = v0[e] * sc; Tb[r * 65 + c + 4 + e] = v1[e] * sc; }
        __syncthreads();
        { const int n = tid >> 3, kk = (tid & 7) * 8; float f[8];
#pragma unroll
          for (int e = 0; e < 8; ++e) f[e] = Tb[(kk + e) * 65 + n];
          *(u32x4*)(cur.dst + (size_t)(cur.n0 + n) * cur.K + cur.k0 + kk) = pack8(f); }
        cur = nxt; v0 = n0v; v1 = n1v; sc = nsc;
    }
    __syncthreads();
}
__device__ void phase_final(const Params& p) {
    const int tid = ltid(), lane = tid & 63, wid = tid >> 6;
    const u64* sumsq = (const u64*)(p.ws + WS_SS) + 4 * MTOK;
    const bf16_t* H = (const bf16_t*)(p.ws + WS_R1);
    for (int row = blockIdx.x * 8 + wid; row < MTOK; row += gridDim.x * 8) {
        const float rs = rsqrtf((float)sumsq[row] * SS_INV + EPS);
        float* xr = p.out + (size_t)row * 1024;
#pragma unroll
        for (int i = 0; i < 2; ++i) { const u32x4 raw = *(const u32x4*)(H + (size_t)row * 1024 + i * 512 + lane * 8); float t[8]; unpack8(raw, t);
            const f32x4 g0 = *(const f32x4*)(p.in[3] + i * 512 + lane * 8), g1 = *(const f32x4*)(p.in[3] + i * 512 + lane * 8 + 4);
            f32x4 v0 = (f32x4){t[0], t[1], t[2], t[3]} * rs * g0, v1 = (f32x4){t[4], t[5], t[6], t[7]} * rs * g1;
            *(f32x4*)(xr + i * 512 + lane * 8) = v0; *(f32x4*)(xr + i * 512 + lane * 8 + 4) = v1; }
    }
}

__device__ __forceinline__ float gelu_tanh(float x) { const float y = 0.7978845608028654f * (x + 0.044715f * x * x * x); const float t = 1.0f - 2.0f * frcp(1.0f + fexp(2.0f * y)); return 0.5f * x * (1.0f + t); }
struct RgW { f32x4 cw[4][2], cb[2]; bf16x8 wB[2][2]; f32x4 gb[2], sp[2]; };
template <bool FINAL> struct RawR { u32x4 xr[4]; u32x4 garaw; float carry; };
__device__ __forceinline__ void rg_load_w(const Params& p, int g, RgW& W) {
    const int tid = ltid(), lane = tid & 63, wid = tid >> 6, fr = lane & 15, fq = lane >> 4;
    const int c8 = (tid & 7) * 8, ch = g * 64 + c8;
    const float* spl = (const float*)(p.ws + WS_MISC + MO_SPL);
    const bf16_t* rgw = (const bf16_t*)(p.ws + WS_MISC + MO_RGW);
#pragma unroll
    for (int w = 0; w < 4; ++w) { W.cw[w][0] = *(const f32x4*)(p.in[8] + w * 512 + ch); W.cw[w][1] = *(const f32x4*)(p.in[8] + w * 512 + ch + 4); }
    W.cb[0] = *(const f32x4*)(p.in[9] + ch); W.cb[1] = *(const f32x4*)(p.in[9] + ch + 4);
    const int mat = wid >> 1, nh = wid & 1, kind = mat >> 1, dirm = mat & 1;
#pragma unroll
    for (int nt = 0; nt < 2; ++nt) { const int col = nh * 32 + nt * 16 + fq * 4;
#pragma unroll
        for (int ks = 0; ks < 2; ++ks) W.wB[nt][ks] = *(const bf16x8*)(rgw + (size_t)(mat * 8 + g) * 4096 + (nh * 32 + nt * 16 + fr) * 64 + ks * 32 + fq * 8);
        W.gb[nt] = *(const f32x4*)((kind ? p.in[13] : p.in[11]) + dirm * 512 + g * 64 + col);
        W.sp[nt] = *(const f32x4*)(spl + dirm * 512 + g * 64 + col); }
}
template <bool FINAL> __device__ __forceinline__ void rg_load(const Params& p, int item, RawR<FINAL>& R) {
    const int tid = ltid();
    const int b = item >> 9, c = (item >> 3) & 63, g = item & 7;
    const bf16_t* proj = (const bf16_t*)(p.ws + WS_A);
    const float* RGH = (const float*)(p.ws + WS_MISC + MO_RGH);
    const int j = tid >> 3, c8 = (tid & 7) * 8, ch = g * 64 + c8;
    const size_t tok = (size_t)b * SEQ + c * 64 + j;
#pragma unroll
    for (int w = 0; w < 4; ++w) { const int tt = c * 64 + j + w - 2; R.xr[w] = (u32x4){0u, 0u, 0u, 0u};
        if (tt >= 0 && tt < SEQ) R.xr[w] = *(const u32x4*)(proj + (size_t)(b * SEQ + tt) * N_AB + ch); }
    const int dc = tid & 127, sdir = dc >> 6, sch = dc & 63;
    const size_t so = ((size_t)(b * 2 + sdir) * 64 + c) * 512 + g * 64 + sch;
    R.carry = 0.f; R.garaw = (u32x4){0u, 0u, 0u, 0u};
    if (FINAL) { R.carry = RGH[so]; R.garaw = *(const u32x4*)(proj + tok * N_AB + 512 + ch); }
}
template <bool FINAL> __device__ __forceinline__ void rg_compute(const Params& p, PG8_LAS unsigned char* lds, int item, const RawR<FINAL>& R, const RgW& W) {
    const int tid = ltid(), lane = tid & 63, wid = tid >> 6, fr = lane & 15, fq = lane >> 4;
    const int b = item >> 9, c = (item >> 3) & 63, g = item & 7;
    lds_f32p xc = (lds_f32p)lds; lds_bf16p xcb = (lds_bf16p)(lds + 16384); lds_f32p LA = (lds_f32p)(lds + 25600); lds_f32p LI = (lds_f32p)(lds + 58368);
    lds_f32p SEGP = (lds_f32p)(lds + 91136); lds_f32p SEGH = (lds_f32p)(lds + 93184);
    float* RGA = (float*)(p.ws + WS_MISC + MO_RGA); float* RGH = (float*)(p.ws + WS_MISC + MO_RGH);
    const int j = tid >> 3, c8 = (tid & 7) * 8, ch = g * 64 + c8;
    const size_t tok = (size_t)b * SEQ + c * 64 + j;
    const int mat = wid >> 1, nh = wid & 1, kind = mat >> 1, dirm = mat & 1;
    const int seg = tid >> 7, dc = tid & 127, sdir = dc >> 6, sch = dc & 63;
    const size_t so = ((size_t)(b * 2 + sdir) * 64 + c) * 512 + g * 64 + sch;
    const float carry = R.carry; const u32x4 garaw = R.garaw;
    { float a[8];
#pragma unroll
      for (int e = 0; e < 4; ++e) { a[e] = W.cb[0][e]; a[4 + e] = W.cb[1][e]; }
#pragma unroll
      for (int w = 0; w < 4; ++w) { float x[8]; unpack8(R.xr[w], x);
#pragma unroll
          for (int e = 0; e < 4; ++e) { a[e] += W.cw[w][0][e] * x[e]; a[4 + e] += W.cw[w][1][e] * x[4 + e]; } }
      f32x4 o0, o1;
#pragma unroll
      for (int e = 0; e < 4; ++e) { o0[e] = a[e]; o1[e] = a[4 + e]; }
      *(PG8_LAS f32x4*)(xc + j * 64 + c8) = o0; *(PG8_LAS f32x4*)(xc + j * 64 + c8 + 4) = o1;
      *(PG8_LAS u32x4*)(xcb + j * 72 + c8) = pack8(a); }
    __syncthreads();
    { f32x4 acc[4][2];
#pragma unroll
      for (int mt = 0; mt < 4; ++mt)
#pragma unroll
          for (int nt = 0; nt < 2; ++nt) acc[mt][nt] = (f32x4){0.f, 0.f, 0.f, 0.f};
#pragma unroll
      for (int ks = 0; ks < 2; ++ks) { bf16x8 a[4];
#pragma unroll
          for (int mt = 0; mt < 4; ++mt) a[mt] = *(PG8_LAS const bf16x8*)(xcb + (mt * 16 + fr) * 72 + ks * 32 + fq * 8);
#pragma unroll
          for (int mt = 0; mt < 4; ++mt)
#pragma unroll
              for (int nt = 0; nt < 2; ++nt) acc[mt][nt] = __builtin_amdgcn_mfma_f32_16x16x32_bf16(W.wB[nt][ks], a[mt], acc[mt][nt], 0, 0, 0); }
      lds_f32p dstp = (kind ? LI : LA) + dirm * 4096;
#pragma unroll
      for (int nt = 0; nt < 2; ++nt) { const int col = nh * 32 + nt * 16 + fq * 4;
#pragma unroll
          for (int mt = 0; mt < 4; ++mt) { const int row = mt * 16 + fr; f32x4 v;
#pragma unroll
              for (int e = 0; e < 4; ++e) { const float sg = sigmoidf_(acc[mt][nt][e] + W.gb[nt][e]); v[e] = kind ? sg : -8.0f * sg * W.sp[nt][e]; }
              *(PG8_LAS f32x4*)(dstp + row * 64 + col) = v; } } }
    __syncthreads();
#pragma unroll
    for (int i = 0; i < 4; ++i) { const int vi = tid + 512 * i, dir = vi >> 10, jj = (vi >> 4) & 63, c4 = (vi & 15) * 4;
        const f32x4 la = *(PG8_LAS f32x4*)(LA + dir * 4096 + jj * 64 + c4), ig = *(PG8_LAS f32x4*)(LI + dir * 4096 + jj * 64 + c4), x = *(PG8_LAS f32x4*)(xc + jj * 64 + c4);
        f32x4 a, u;
#pragma unroll
        for (int e = 0; e < 4; ++e) { a[e] = fexp(la[e]);
            const float x2 = 2.0f * la[e]; const float om = x2 > -0.3f ? -x2 * (1.0f + x2 * (0.5f + x2 * (0.16666667f + x2 * (0.041666668f + x2 * 0.0083333338f)))) : 1.0f - a[e] * a[e];
            u[e] = __builtin_amdgcn_sqrtf(fmaxf(om, 0.f)) * ig[e] * x[e]; }
        *(PG8_LAS f32x4*)(LA + dir * 4096 + jj * 64 + c4) = a; *(PG8_LAS f32x4*)(LI + dir * 4096 + jj * 64 + c4) = u; }
    __syncthreads();
    { float a[16], u[16]; float hl = 0.f, Pl = 1.f;
#pragma unroll
      for (int e = 0; e < 16; ++e) { const int jj = seg * 16 + e, jr = sdir ? 63 - jj : jj; a[e] = LA[sdir * 4096 + jr * 64 + sch]; u[e] = LI[sdir * 4096 + jr * 64 + sch]; }
#pragma unroll
      for (int e = 0; e < 16; ++e) { hl = a[e] * hl + u[e]; Pl *= a[e]; }
      SEGP[seg * 128 + dc] = Pl; SEGH[seg * 128 + dc] = hl;
      __syncthreads();
      float H = carry, Pt = 1.f;
#pragma unroll
      for (int s = 0; s < 3; ++s) { const float ps = SEGP[s * 128 + dc], hs = SEGH[s * 128 + dc]; if (s < seg) { H = ps * H + hs; Pt *= ps; } }
      if (FINAL) {
#pragma unroll
          for (int e = 0; e < 16; ++e) { const int jj = seg * 16 + e, jr = sdir ? 63 - jj : jj; H = a[e] * H + u[e]; LI[sdir * 4096 + jr * 64 + sch] = H; }
      } else if (seg == 3) { RGA[so] = Pt * Pl; RGH[so] = Pl * H + hl; } }
    if (FINAL) {
        __syncthreads();
        float ga[8], o[8]; unpack8(garaw, ga);
#pragma unroll
        for (int e = 0; e < 8; ++e) o[e] = (LI[j * 64 + c8 + e] + LI[4096 + j * 64 + c8 + e]) * gelu_tanh(ga[e]);
        *(u32x4*)((bf16_t*)p.out + tok * 1024 + ch) = pack8(o);
    }
    __syncthreads();
}
__device__ void rg_carry(const Params& p) {
    float* RGA = (float*)(p.ws + WS_MISC + MO_RGA); float* RGH = (float*)(p.ws + WS_MISC + MO_RGH);
    const int idx = blockIdx.x * 512 + ltid();
    if (idx < 8192) { const int bd = idx >> 9, dir = bd & 1, ch = idx & 511; const size_t base = (size_t)bd * 64 * 512 + ch; float H = 0.f;
        for (int cb = 0; cb < 64; cb += 8) { float a[8], he[8];
#pragma unroll
            for (int e = 0; e < 8; ++e) { const int c = dir ? 63 - (cb + e) : cb + e; a[e] = RGA[base + c * 512]; he[e] = RGH[base + c * 512]; }
#pragma unroll
            for (int e = 0; e < 8; ++e) { const int c = dir ? 63 - (cb + e) : cb + e; RGH[base + c * 512] = H; H = a[e] * H + he[e]; } } }
}

constexpr int LDS_SEGT = 131072, LDS_RED = 133120;
__device__ __forceinline__ void hg_gate(const u32x4 raw, const float (&lb)[8], float (&lf)[8], float (&k)[8]) {
    float x[8]; unpack8(raw, x);
#pragma unroll
    for (int e = 0; e < 8; ++e) { const float ex = fexp(-x[e]), sg = frcp(1.0f + ex); lf[e] = flog(lb[e] + (1.0f - lb[e]) * sg); k[e] = (1.0f - lb[e]) * ex * sg; }
}
__device__ __forceinline__ void gla_gate(const bf16x8 wB, const bf16x8 (&lrA)[4], const f32x4 bias, lds_f32p cum, int wid, int fr, int fq) {
#pragma unroll
    for (int mt = 0; mt < 4; ++mt) { f32x4 z = __builtin_amdgcn_mfma_f32_16x16x32_bf16(wB, lrA[mt], (f32x4){0.f, 0.f, 0.f, 0.f}, 0, 0, 0);
#pragma unroll
        for (int e = 0; e < 4; ++e) { const float zz = z[e] + bias[e]; z[e] = (fminf(zz, 0.f) - flog(1.0f + fexp(-fabsf(zz)))) * (1.0f / 16.0f); }
        *(PG8_LAS f32x4*)(cum + (mt * 16 + fr) * 128 + wid * 16 + fq * 4) = z; }
}
__device__ __forceinline__ void chunk_scan(lds_f32p cum, lds_f32p segt, int dir, int tid) {
    const int seg = tid >> 7, d = tid & 127; float v[16], run = 0.f;
#pragma unroll
    for (int e = 0; e < 16; ++e) { const int jj = seg * 16 + e, j = dir ? 63 - jj : jj; v[e] = cum[j * 128 + d]; }
#pragma unroll
    for (int e = 0; e < 16; ++e) { run += v[e]; v[e] = run; }
    segt[seg * 128 + d] = run;
    __syncthreads();
    float off = 0.f;
#pragma unroll
    for (int s = 0; s < 3; ++s) { const float t = segt[s * 128 + d]; if (s < seg) off += t; }
#pragma unroll
    for (int e = 0; e < 16; ++e) { const int jj = seg * 16 + e, j = dir ? 63 - jj : jj; cum[j * 128 + d] = v[e] + off; }
}
typedef short s16x4 __attribute__((ext_vector_type(4)));
__device__ __forceinline__ bf16x8 frag_tr(PG8_LAS const bf16_t* img, int ld, int k0, int n0, int lane) {
    const int g = lane >> 4, q = (lane & 15) >> 2, pp = lane & 3;
    PG8_LAS const bf16_t* a0 = img + (k0 + 8 * g + q) * ld + n0 + 4 * pp;
    const s16x4 lo = __builtin_amdgcn_ds_read_tr16_b64_v4i16((PG8_LAS s16x4*)a0);
    const s16x4 hi = __builtin_amdgcn_ds_read_tr16_b64_v4i16((PG8_LAS s16x4*)(a0 + 4 * ld));
    return (bf16x8){lo[0], lo[1], lo[2], lo[3], hi[0], hi[1], hi[2], hi[3]};
}
__device__ __forceinline__ bf16x8 frag_tr_perm(PG8_LAS const bf16_t* img, int ld, int k0, int nb, int off, int lane) {
    const int g = lane >> 4, q = (lane & 15) >> 2, pp = lane & 3;
    PG8_LAS const bf16_t* a0 = img + (k0 + 8 * g + q) * ld + nb + 8 * pp + off;
    const s16x4 lo = __builtin_amdgcn_ds_read_tr16_b64_v4i16((PG8_LAS s16x4*)a0);
    const s16x4 hi = __builtin_amdgcn_ds_read_tr16_b64_v4i16((PG8_LAS s16x4*)(a0 + 4 * ld));
    return (bf16x8){lo[0], lo[1], lo[2], lo[3], hi[0], hi[1], hi[2], hi[3]};
}
template <int DV> __device__ __forceinline__ void store_v(const u32x4 (&vraw)[DV / 64], lds_bf16p V, int tid) {
    constexpr int G8 = DV / 8;
#pragma unroll
    for (int i = 0; i < DV / 64; ++i) { const int idx = tid + 512 * i, j = idx / G8, c8 = (idx % G8) * 8; *(PG8_LAS u32x4*)(V + j * (DV + 16) + c8) = vraw[i]; }
}
template <bool GLA> struct RawA { u32x4 v[GLA ? 4 : 2]; u32x4 k[GLA ? 2 : 4]; };
template <bool GLA> __device__ __forceinline__ void mix_a_load(const Params& p, int it, int half, RawA<GLA>& R) {
    constexpr int DV = GLA ? 256 : 128, G8 = DV / 8;
    const int c = it & 63, h = (it >> 6) & 3, bl = it >> 8, b = half * 4 + bl;
    const int tid = ltid(), lane = tid & 63, wid = tid >> 6, fr = lane & 15, fq = lane >> 4;
    const size_t tok0 = (size_t)b * SEQ + c * 64;
    const bf16_t* proj = (const bf16_t*)(p.ws + WS_A);
    const int d8 = (tid & 15) * 8, jb = tid >> 4;
#pragma unroll
    for (int i = 0; i < DV / 64; ++i) { const int idx = tid + 512 * i, j = idx / G8, c8 = (idx % G8) * 8;
        R.v[i] = *(const u32x4*)(GLA ? proj + (tok0 + j) * N_GLA + 1024 + h * 256 + c8 : proj + (tok0 + j) * N_AB + 2560 + h * 128 + c8); }
#pragma unroll
    for (int i = 0; i < 2; ++i) { const int j = jb + 32 * i;
        if (GLA) R.k[i] = *(const u32x4*)(proj + (tok0 + j) * N_GLA + 512 + h * 128 + d8);
        else { const bf16_t* rp = proj + (tok0 + j) * N_AB + 1536 + h * 128 + d8; R.k[i] = *(const u32x4*)rp; R.k[GLA ? 0 : 2 + i] = *(const u32x4*)(rp + 512); } }
}
template <bool GLA> __device__ __forceinline__ void mix_a_compute(const Params& p, PG8_LAS unsigned char* lds, int it, int half, const RawA<GLA>& R) {
    constexpr int DV = GLA ? 256 : 128;
    const int c = it & 63, h = (it >> 6) & 3, bl = it >> 8;
    const int tid = ltid(), lane = tid & 63, wid = tid >> 6, fr = lane & 15, fq = lane >> 4;
    lds_f32p cum = (lds_f32p)lds; lds_bf16p ksT = (lds_bf16p)(lds + 32768); lds_bf16p vT = (lds_bf16p)(lds + 51200); lds_f32p segt = (lds_f32p)(lds + LDS_SEGT);
    const int d8 = (tid & 15) * 8, jb = tid >> 4;
    bf16x8 lrA[4], wB[2]; f32x4 bias[2];
    if (GLA) { const bf16_t* proj = (const bf16_t*)(p.ws + WS_A); const size_t tok0 = (size_t)(half * 4 + bl) * SEQ + c * 64;
#pragma unroll
        for (int mt = 0; mt < 4; ++mt) lrA[mt] = *(const bf16x8*)(proj + (tok0 + mt * 16 + fr) * N_GLA + 3072 + fq * 8);
#pragma unroll
        for (int dir = 0; dir < 2; ++dir) { wB[dir] = (bf16x8){0, 0, 0, 0, 0, 0, 0, 0};
            if ((fq >> 1) == dir) wB[dir] = *(const bf16x8*)((const bf16_t*)(p.ws + WS_MISC + MO_WUPT) + (size_t)(dir * 512 + h * 128 + wid * 16 + fr) * 16 + (fq & 1) * 8);
            bias[dir] = *(const f32x4*)(p.in[20] + dir * 512 + h * 128 + wid * 16 + fq * 4); } }
    float lb[8];
    if (!GLA) { const float* lbv = (const float*)(p.ws + WS_MISC + MO_LBV) + h * 128 + d8; const f32x4 l0 = *(const f32x4*)lbv, l1 = *(const f32x4*)(lbv + 4);
#pragma unroll
        for (int e = 0; e < 4; ++e) { lb[e] = l0[e]; lb[4 + e] = l1[e]; } }
    store_v<DV>(R.v, vT, tid);
#pragma unroll
    for (int dir = 0; dir < 2; ++dir) {
        const int chain = ((half * 4 + bl) * 4 + h) * 2 + dir;
        bf16_t* st = (GLA ? gla_state(p, chain) : (bf16_t*)(p.ws + WS_ST) + (size_t)chain * 64 * DV * 128) + (size_t)c * DV * 128;
        float* decay = (float*)(p.ws + WS_MISC + MO_DECAY) + ((size_t)chain * 64 + c) * 128;
        float kk[2][8];
        if (GLA) {
            gla_gate(wB[dir], lrA, bias[dir], cum, wid, fr, fq);
#pragma unroll
            for (int i = 0; i < 2; ++i) unpack8(R.k[i], kk[i]);
        } else {
#pragma unroll
            for (int i = 0; i < 2; ++i) { const int j = jb + 32 * i; float lf[8]; hg_gate(R.k[GLA ? 0 : dir * 2 + i], lb, lf, kk[i]);
                *(PG8_LAS f32x4*)(cum + j * 128 + d8) = (f32x4){lf[0], lf[1], lf[2], lf[3]}; *(PG8_LAS f32x4*)(cum + j * 128 + d8 + 4) = (f32x4){lf[4], lf[5], lf[6], lf[7]}; }
        }
        __syncthreads();
        chunk_scan(cum, segt, dir, tid);
        __syncthreads();
        { const int lrow = dir ? 0 : 63;
          float last[8]; { const f32x4 l0 = *(PG8_LAS f32x4*)(cum + lrow * 128 + d8), l1 = *(PG8_LAS f32x4*)(cum + lrow * 128 + d8 + 4);
#pragma unroll
              for (int e = 0; e < 4; ++e) { last[e] = l0[e]; last[4 + e] = l1[e]; } }
#pragma unroll
          for (int i = 0; i < 2; ++i) { const int j = jb + 32 * i; const f32x4 c0 = *(PG8_LAS f32x4*)(cum + j * 128 + d8), c1 = *(PG8_LAS f32x4*)(cum + j * 128 + d8 + 4);
              float ks[8];
#pragma unroll
              for (int e = 0; e < 8; ++e) { const float cv = e < 4 ? c0[e] : c1[e - 4]; ks[e] = kk[i][e] * fexp(last[e] - cv); }
              *(PG8_LAS u32x4*)(ksT + j * 144 + d8) = pack8(ks); }
          if (tid < 128) decay[tid] = fexp(cum[lrow * 128 + tid]); }
        __syncthreads();
        { constexpr int MT = DV / 64; const int m0 = (wid >> 1) * (DV / 4), n0 = (wid & 1) * 64;
          f32x4 acc[MT][4];
#pragma unroll
          for (int mt = 0; mt < MT; ++mt)
#pragma unroll
              for (int nt = 0; nt < 4; ++nt) acc[mt][nt] = (f32x4){0.f, 0.f, 0.f, 0.f};
#pragma unroll
          for (int ks = 0; ks < 2; ++ks) { bf16x8 a[MT], bq[4];
#pragma unroll
              for (int mt = 0; mt < MT; ++mt) a[mt] = frag_tr((PG8_LAS const bf16_t*)vT, DV + 16, ks * 32, m0 + mt * 16, lane);
#pragma unroll
              for (int nt = 0; nt < 4; ++nt) bq[nt] = frag_tr_perm((PG8_LAS const bf16_t*)ksT, 144, ks * 32, n0 + (nt >> 1) * 32, (nt & 1) * 4, lane);
#pragma unroll
              for (int mt = 0; mt < MT; ++mt)
#pragma unroll
                  for (int nt = 0; nt < 4; ++nt) acc[mt][nt] = __builtin_amdgcn_mfma_f32_16x16x32_bf16(bq[nt], a[mt], acc[mt][nt], 0, 0, 0); }
#pragma unroll
          for (int mt = 0; mt < MT; ++mt)
#pragma unroll
              for (int k = 0; k < 2; ++k) { u32x4 pk; pk[0] = cvt_pk_bf16(acc[mt][2 * k][0], acc[mt][2 * k][1]); pk[1] = cvt_pk_bf16(acc[mt][2 * k][2], acc[mt][2 * k][3]);
                  pk[2] = cvt_pk_bf16(acc[mt][2 * k + 1][0], acc[mt][2 * k + 1][1]); pk[3] = cvt_pk_bf16(acc[mt][2 * k + 1][2], acc[mt][2 * k + 1][3]);
                  *(u32x4*)(st + (size_t)(m0 + mt * 16 + fr) * 128 + n0 + k * 32 + fq * 8) = pk; } }
    }
    __syncthreads();
}
template <int DV, bool GLA> __device__ void state_scan(const Params& p, const float* decay, int chain0, int nchains, PG8_LAS unsigned char* lds) {
    constexpr int ELEMS = DV * 128, SL = ELEMS / 4096;
    const int tid = ltid();
    lds_f32p dl = (lds_f32p)lds;
    for (int item = blockIdx.x; item < nchains * SL; item += gridDim.x) {
        const int cl = item / SL, chain = chain0 + cl, sl = item - cl * SL, dir = chain & 1, e0 = sl * 4096 + tid * 8, d8 = e0 & 127;
        bf16_t* sp = (GLA ? gla_state(p, chain) : (bf16_t*)(p.ws + WS_ST) + (size_t)chain * 64 * ELEMS) + e0; const float* dp = decay + (size_t)chain * 64 * 128;
#pragma unroll
        for (int i = 0; i < 4; ++i) *(PG8_LAS f32x4*)(dl + (tid + 512 * i) * 4) = *(const f32x4*)(dp + (tid + 512 * i) * 4);
        __syncthreads();
        float S[8];
#pragma unroll
        for (int e = 0; e < 8; ++e) S[e] = 0.f;
        for (int cb = 0; cb < 64; cb += 8) { u32x4 raw[8];
#pragma unroll
            for (int q = 0; q < 8; ++q) { const int c = dir ? 63 - (cb + q) : cb + q; raw[q] = *(const u32x4*)(sp + (size_t)c * ELEMS); }
#pragma unroll
            for (int q = 0; q < 8; ++q) { const int c = dir ? 63 - (cb + q) : cb + q; float u[8]; unpack8(raw[q], u);
                const f32x4 dc0 = *(PG8_LAS f32x4*)(dl + c * 128 + d8), dc1 = *(PG8_LAS f32x4*)(dl + c * 128 + d8 + 4);
                *(u32x4*)(sp + (size_t)c * ELEMS) = pack8(S);
#pragma unroll
                for (int e = 0; e < 8; ++e) S[e] = (e < 4 ? dc0[e] : dc1[e - 4]) * S[e] + u[e]; } }
        __syncthreads();
    }
}
template <bool GLA> struct RawC { u32x4 v[GLA ? 4 : 2]; u32x4 k[GLA ? 1 : 4]; };
template <bool GLA> __device__ __forceinline__ void mix_c_load(const Params& p, int it, int half, RawC<GLA>& R) {
    constexpr int DV = GLA ? 256 : 128, G8 = DV / 8;
    const int c = it & 63, h = (it >> 6) & 3, bl = it >> 8, b = half * 4 + bl;
    const int tid = ltid(), lane = tid & 63, wid = tid >> 6, fr = lane & 15, fq = lane >> 4;
    const size_t tok0 = (size_t)b * SEQ + c * 64;
    const bf16_t* proj = (const bf16_t*)(p.ws + WS_A);
    const int d8 = (tid & 15) * 8, jb = tid >> 4;
#pragma unroll
    for (int i = 0; i < DV / 64; ++i) { const int idx = tid + 512 * i, j = idx / G8, c8 = (idx % G8) * 8;
        R.v[i] = *(const u32x4*)(GLA ? proj + (tok0 + j) * N_GLA + 1024 + h * 256 + c8 : proj + (tok0 + j) * N_AB + 2560 + h * 128 + c8); }
#pragma unroll
    for (int i = 0; i < 2; ++i) { const int j = jb + 32 * i;
        if (!GLA) { const bf16_t* rp = proj + (tok0 + j) * N_AB + h * 128 + d8; R.k[i] = *(const u32x4*)(rp + 1536); R.k[GLA ? 0 : 2 + i] = *(const u32x4*)(rp + 2048); } }
}
template <bool GLA> __device__ __forceinline__ void mix_c_compute(const Params& p, PG8_LAS unsigned char* lds, int it, int half, const RawC<GLA>& R) {
    constexpr int DV = GLA ? 256 : 128, NT = DV / 128;
    const int c = it & 63, h = (it >> 6) & 3, bl = it >> 8, b = half * 4 + bl;
    const int tid = ltid(), lane = tid & 63, wid = tid >> 6, fr = lane & 15, fq = lane >> 4;
    lds_f32p cum = (lds_f32p)lds; lds_bf16p qin = (lds_bf16p)(lds + 32768); lds_bf16p kin = (lds_bf16p)(lds + 50176); lds_bf16p qc = (lds_bf16p)(lds + 67584);
    lds_bf16p P = (lds_bf16p)(lds + 84992); lds_bf16p vT = (lds_bf16p)(lds + 94208); lds_f32p segt = (lds_f32p)(lds + LDS_SEGT); lds_f32p red = (lds_f32p)(lds + LDS_RED);
    const size_t tok0 = (size_t)b * SEQ + c * 64;
    const bf16_t* proj = (const bf16_t*)(p.ws + WS_A);
    const int d8 = (tid & 15) * 8, jb = tid >> 4, n0 = wid * NT * 16;
    u32x4 qraw[2], kg[2];
#pragma unroll
    for (int i = 0; i < 2; ++i) { const int j = jb + 32 * i;
        if (GLA) { const bf16_t* rp = proj + (tok0 + j) * N_GLA + h * 128 + d8; qraw[i] = *(const u32x4*)rp; kg[i] = *(const u32x4*)(rp + 512); }
        else { qraw[i] = *(const u32x4*)(proj + (tok0 + j) * N_AB + 1024 + h * 128 + d8); kg[i] = qraw[i]; } }
    bf16x8 lrA[4], wB[2]; f32x4 gbias[2];
    if (GLA) {
#pragma unroll
        for (int mt = 0; mt < 4; ++mt) lrA[mt] = *(const bf16x8*)(proj + (tok0 + mt * 16 + fr) * N_GLA + 3072 + fq * 8);
#pragma unroll
        for (int dir = 0; dir < 2; ++dir) { wB[dir] = (bf16x8){0, 0, 0, 0, 0, 0, 0, 0};
            if ((fq >> 1) == dir) wB[dir] = *(const bf16x8*)((const bf16_t*)(p.ws + WS_MISC + MO_WUPT) + (size_t)(dir * 512 + h * 128 + wid * 16 + fr) * 16 + (fq & 1) * 8);
            gbias[dir] = *(const f32x4*)(p.in[20] + dir * 512 + h * 128 + wid * 16 + fq * 4); }
    }
    float lb[8];
    if (!GLA) { const float* lbv = (const float*)(p.ws + WS_MISC + MO_LBV) + h * 128 + d8; const f32x4 l0 = *(const f32x4*)lbv, l1 = *(const f32x4*)(lbv + 4);
#pragma unroll
        for (int e = 0; e < 4; ++e) { lb[e] = l0[e]; lb[4 + e] = l1[e]; } }
    store_v<DV>(R.v, vT, tid);
    f32x4 o[4][NT];
#pragma unroll
    for (int mt = 0; mt < 4; ++mt)
#pragma unroll
        for (int nt = 0; nt < NT; ++nt) o[mt][nt] = (f32x4){0.f, 0.f, 0.f, 0.f};
#pragma unroll
    for (int dir = 0; dir < 2; ++dir) {
        bf16x8 sB[NT][4];
        { const int chain = ((half * 4 + bl) * 4 + h) * 2 + dir;
          const bf16_t* st = (GLA ? gla_state(p, chain) : (bf16_t*)(p.ws + WS_ST) + (size_t)chain * 64 * DV * 128) + (size_t)c * DV * 128;
#pragma unroll
          for (int nt = 0; nt < NT; ++nt)
#pragma unroll
              for (int ks = 0; ks < 4; ++ks) sB[nt][ks] = *(const bf16x8*)(st + (size_t)(NT == 2 ? n0 + (fr >> 2) * 8 + nt * 4 + (fr & 3) : n0 + nt * 16 + fr) * 128 + ks * 32 + fq * 8); }
        float kk[2][8];
        if (GLA) { gla_gate(wB[dir], lrA, gbias[dir], cum, wid, fr, fq);
#pragma unroll
            for (int i = 0; i < 2; ++i) unpack8(kg[i], kk[i]);
        } else {
#pragma unroll
            for (int i = 0; i < 2; ++i) { const int j = jb + 32 * i; float lf[8]; hg_gate(R.k[GLA ? 0 : dir * 2 + i], lb, lf, kk[i]);
                *(PG8_LAS f32x4*)(cum + j * 128 + d8) = (f32x4){lf[0], lf[1], lf[2], lf[3]}; *(PG8_LAS f32x4*)(cum + j * 128 + d8 + 4) = (f32x4){lf[4], lf[5], lf[6], lf[7]}; }
        }
        __syncthreads();
        chunk_scan(cum, segt, dir, tid);
        __syncthreads();
        { const int jref = dir ? 31 : 32;
          float ref[8]; { const f32x4 l0 = *(PG8_LAS f32x4*)(cum + jref * 128 + d8), l1 = *(PG8_LAS f32x4*)(cum + jref * 128 + d8 + 4);
#pragma unroll
              for (int e = 0; e < 4; ++e) { ref[e] = l0[e]; ref[4 + e] = l1[e]; } }
#pragma unroll
          for (int i = 0; i < 2; ++i) { const int j = jb + 32 * i; const f32x4 c0 = *(PG8_LAS f32x4*)(cum + j * 128 + d8), c1 = *(PG8_LAS f32x4*)(cum + j * 128 + d8 + 4);
              float q[8], a[8], bb[8], cc[8]; unpack8(qraw[i], q);
#pragma unroll
              for (int e = 0; e < 8; ++e) { const float cv = e < 4 ? c0[e] : c1[e - 4];
                  const float qq = GLA ? q[e] * 0.08838834764831845f : q[e] * frcp(1.0f + fexp(-q[e]));
                  a[e] = qq * fexp(cv - ref[e]); bb[e] = kk[i][e] * fexp(ref[e] - cv); cc[e] = qq * fexp(cv); }
              *(PG8_LAS u32x4*)(qin + j * 136 + d8) = pack8(a); *(PG8_LAS u32x4*)(kin + j * 136 + d8) = pack8(bb); *(PG8_LAS u32x4*)(qc + j * 136 + d8) = pack8(cc); } }
        __syncthreads();
        { f32x4 s[1][2]; s[0][0] = (f32x4){0.f, 0.f, 0.f, 0.f}; s[0][1] = s[0][0];
          const int m0 = (wid & 3) * 16, l = m0 + fr, sn0 = (wid >> 2) * 32;
          mma_tiles<1, 2, false, false, 128>(s, (PG8_LAS const bf16_t*)qin, 136, m0, (PG8_LAS const bf16_t*)kin, 136, sn0, fr, fq);
#pragma unroll
          for (int nt = 0; nt < 2; ++nt) { const int mc = sn0 + nt * 16 + fq * 4; float v[4];
#pragma unroll
              for (int e = 0; e < 4; ++e) { const bool keep = dir ? (l <= mc + e) : (l >= mc + e); v[e] = keep ? s[0][nt][e] : 0.f; }
              u32x2 pk; pk[0] = cvt_pk_bf16(v[0], v[1]); pk[1] = cvt_pk_bf16(v[2], v[3]); *(PG8_LAS u32x2*)(P + l * 72 + mc) = pk; } }
        __syncthreads();
#pragma unroll
        for (int ks = 0; ks < 2; ++ks) { bf16x8 a[4], bq[NT];
#pragma unroll
            for (int mt = 0; mt < 4; ++mt) a[mt] = *(PG8_LAS const bf16x8*)(P + (mt * 16 + fr) * 72 + ks * 32 + fq * 8);
#pragma unroll
            for (int nt = 0; nt < NT; ++nt) bq[nt] = NT == 2 ? frag_tr_perm((PG8_LAS const bf16_t*)vT, DV + 16, ks * 32, n0, nt * 4, lane) : frag_tr((PG8_LAS const bf16_t*)vT, DV + 16, ks * 32, n0 + nt * 16, lane);
#pragma unroll
            for (int mt = 0; mt < 4; ++mt)
#pragma unroll
                for (int nt = 0; nt < NT; ++nt) o[mt][nt] = __builtin_amdgcn_mfma_f32_16x16x32_bf16(bq[nt], a[mt], o[mt][nt], 0, 0, 0); }
#pragma unroll
        for (int ks = 0; ks < 4; ++ks) { bf16x8 a[4];
#pragma unroll
            for (int mt = 0; mt < 4; ++mt) a[mt] = *(PG8_LAS const bf16x8*)(qc + (mt * 16 + fr) * 136 + ks * 32 + fq * 8);
#pragma unroll
            for (int mt = 0; mt < 4; ++mt)
#pragma unroll
                for (int nt = 0; nt < NT; ++nt) o[mt][nt] = __builtin_amdgcn_mfma_f32_16x16x32_bf16(sB[nt][ks], a[mt], o[mt][nt], 0, 0, 0);
            if (ks & 1) __builtin_amdgcn_sched_barrier(0); }
        __builtin_amdgcn_sched_barrier(0);
    }
    const float* gain = (GLA ? p.in[21] : p.in[16]) + h * DV;
    u32x2 graw[4][NT];
#pragma unroll
    for (int mt = 0; mt < 4; ++mt)
#pragma unroll
        for (int nt = 0; nt < NT; ++nt) { const size_t tok = tok0 + mt * 16 + fr; const int col = NT == 2 ? n0 + fq * 8 + nt * 4 : n0 + nt * 16 + fq * 4;
            graw[mt][nt] = *(const u32x2*)(GLA ? proj + tok * N_GLA + 2048 + h * 256 + col : proj + tok * N_AB + 3072 + h * 128 + col); }
#pragma unroll
    for (int mt = 0; mt < 4; ++mt) { float ss = 0.f;
#pragma unroll
        for (int nt = 0; nt < NT; ++nt)
#pragma unroll
            for (int e = 0; e < 4; ++e) ss += o[mt][nt][e] * o[mt][nt][e];
        ss += __shfl_xor(ss, 16); ss += __shfl_xor(ss, 32);
        if (fq == 0) red[wid * 64 + mt * 16 + fr] = ss; }
    __syncthreads();
#pragma unroll
    for (int mt = 0; mt < 4; ++mt) { const int row = mt * 16 + fr; float tot = 0.f;
#pragma unroll
        for (int w = 0; w < 8; ++w) tot += red[w * 64 + row];
        const float rstd = rsqrtf(tot * (1.0f / DV) + EPS);
        bf16_t* outp = (bf16_t*)p.out + (tok0 + row) * 1024 + (GLA ? 0 : 512) + h * DV;
        unsigned pkw[2 * NT];
#pragma unroll
        for (int nt = 0; nt < NT; ++nt) { const int col = NT == 2 ? n0 + fq * 8 + nt * 4 : n0 + nt * 16 + fq * 4; const f32x4 gn = *(const f32x4*)(gain + col); float y[4];
#pragma unroll
            for (int e = 0; e < 4; ++e) { const unsigned wv = graw[mt][nt][e >> 1]; const float gv = __uint_as_float((e & 1) ? (wv & 0xffff0000u) : (wv << 16));
                y[e] = o[mt][nt][e] * rstd * gn[e] * (gv * frcp(1.0f + fexp(-gv))); }
            pkw[2 * nt] = cvt_pk_bf16(y[0], y[1]); pkw[2 * nt + 1] = cvt_pk_bf16(y[2], y[3]); }
        if (NT == 2) { u32x4 pk; pk[0] = pkw[0]; pk[1] = pkw[1]; pk[2] = pkw[2 * NT - 2]; pk[3] = pkw[2 * NT - 1]; *(u32x4*)(outp + n0 + fq * 8) = pk; }
        else { u32x2 pk; pk[0] = pkw[0]; pk[1] = pkw[1]; *(u32x2*)(outp + n0 + fq * 4) = pk; } }
    __syncthreads();
}

template <bool GLA> __device__ __forceinline__ void mix_a_phase(const Params& p, PG8_LAS unsigned char* lds, int nitems, int half) {
    RawA<GLA> A{}, B{}; int it = blockIdx.x; const int G = gridDim.x; if (it < nitems) mix_a_load<GLA>(p, it, half, A);
    while (it < nitems) {
        if (it + G < nitems) mix_a_load<GLA>(p, it + G, half, B);
        mix_a_compute<GLA>(p, lds, it, half, A); it += G; if (it >= nitems) break;
        if (it + G < nitems) mix_a_load<GLA>(p, it + G, half, A);
        mix_a_compute<GLA>(p, lds, it, half, B); it += G; }
}
template <bool GLA> __device__ __forceinline__ void mix_c_phase(const Params& p, PG8_LAS unsigned char* lds, int nitems, int half) {
    RawC<GLA> A{}, B{}; int it = blockIdx.x; const int G = gridDim.x; if (it < nitems) mix_c_load<GLA>(p, it, half, A);
    while (it < nitems) {
        if (it + G < nitems) mix_c_load<GLA>(p, it + G, half, B);
        mix_c_compute<GLA>(p, lds, it, half, A); it += G; if (it >= nitems) break;
        if (it + G < nitems) mix_c_load<GLA>(p, it + G, half, A);
        mix_c_compute<GLA>(p, lds, it, half, B); it += G; }
}
template <bool FINAL> __device__ __forceinline__ void rg_phase(const Params& p, PG8_LAS unsigned char* lds) {
    RawR<FINAL> A{}, B{}; RgW W{}; int it = blockIdx.x; const int G = gridDim.x; const bool gconst = (G & 7) == 0;
    if (it < 4096) { rg_load_w(p, it & 7, W); rg_load<FINAL>(p, it, A); }
    while (it < 4096) {
        if (it + G < 4096) rg_load<FINAL>(p, it + G, B);
        if (!gconst) rg_load_w(p, it & 7, W);
        rg_compute<FINAL>(p, lds, it, A, W); it += G; if (it >= 4096) break;
        if (it + G < 4096) rg_load<FINAL>(p, it + G, A);
        if (!gconst) rg_load_w(p, it & 7, W);
        rg_compute<FINAL>(p, lds, it, B, W); it += G; }
}
#define XB_TMO      128
#define XB_XCNT(j)  (256  + 64 * (j))
#define XB_XSUB(j)  (1280 + 64 * (j))
#define XB_XGEN(j)  (2304 + 64 * (j))
#define XB_TOP      3328
#define XB_TOPGEN   3392
#define XCD_BAR_WORDS 3456
#define XB_SPIN_CAP (1u << 18)
#define LAS __attribute__((address_space(3)))

__device__ __forceinline__ unsigned xb_ld(unsigned* p)              { return __hip_atomic_load(p, __ATOMIC_RELAXED, __HIP_MEMORY_SCOPE_AGENT); }
__device__ __forceinline__ unsigned xb_add(unsigned* p, unsigned v) { return __hip_atomic_fetch_add(p, v, __ATOMIC_RELAXED, __HIP_MEMORY_SCOPE_AGENT); }
__device__ __forceinline__ unsigned xb_xcc_id() { return (unsigned)__builtin_amdgcn_s_getreg((3 << 11) | 20) & 0xFu; }
#define XB_SPIN(cond, bar) do { unsigned _sp = 0; while (cond) { __builtin_amdgcn_s_sleep(1); \
    if ((++_sp & 255u) == 0u) { if (xb_ld(&(bar)[XB_TMO])) break; if (_sp > XB_SPIN_CAP) { atomicAdd(&(bar)[XB_TMO], 1u); break; } } } } while (0)

struct XcdBarrier {
    unsigned* bar; unsigned x;
    volatile LAS unsigned* st;
};

__device__ __forceinline__ XcdBarrier xcd_barrier_post(unsigned* bar, volatile LAS unsigned* st) {
    XcdBarrier b; b.bar = bar; b.x = xb_xcc_id(); b.st = st;
    if (threadIdx.x == 0) (void)xb_add(&bar[XB_XCNT(b.x)], 1u);
    return b;
}
__device__ __forceinline__ void xcd_barrier_complete(unsigned* bar, unsigned x, unsigned& nloc, unsigned& nx) {
    const unsigned G = gridDim.x * gridDim.y * gridDim.z;
    unsigned sum, cnt, mine, sp = 0u;
    for (;;) {
        sum = 0u; cnt = 0u; mine = 0u;
#pragma unroll
        for (unsigned j = 0; j < 16; ++j) { const unsigned c = xb_ld(&bar[XB_XCNT(j)]); sum += c; cnt += (c > 0u) ? 1u : 0u; mine = (j == x) ? c : mine; }
        if (sum == G) break;
        __builtin_amdgcn_s_sleep(1);
        if ((++sp & 255u) == 0u) { if (xb_ld(&bar[XB_TMO])) break; if (sp > XB_SPIN_CAP) { atomicAdd(&bar[XB_TMO], 1u); break; } }
    }
    nloc = mine > 0u ? mine : 1u; nx = cnt > 0u ? cnt : 1u;
}

__device__ __forceinline__ void xcd_barrier(const XcdBarrier& b) {
    asm volatile("s_waitcnt vmcnt(0)" ::: "memory");
    __syncthreads();
    if (threadIdx.x == 0) {
        unsigned* bar = b.bar;
        __builtin_amdgcn_s_waitcnt(0);
        unsigned nloc = b.st[0], nx = b.st[1];
        if (nloc == 0u) { xcd_barrier_complete(bar, b.x, nloc, nx); b.st[0] = nloc; b.st[1] = nx; }
        const unsigned old = xb_add(&bar[XB_XSUB(b.x)], 1u);
        const unsigned gen = old / nloc;
        if (old + 1u == (gen + 1u) * nloc) {
            __builtin_amdgcn_fence(__ATOMIC_RELEASE, "agent");
            asm volatile("s_waitcnt vmcnt(0)" ::: "memory");
            const unsigned og = xb_add(&bar[XB_TOP], 1u);
            const unsigned tg = og / nx;
            if (og + 1u == (tg + 1u) * nx) xb_add(&bar[XB_TOPGEN], 1u);
            else XB_SPIN(xb_ld(&bar[XB_TOPGEN]) == tg, bar);
            __builtin_amdgcn_fence(__ATOMIC_ACQUIRE, "agent");
            xb_add(&bar[XB_XGEN(b.x)], 1u);
            asm volatile("s_waitcnt vmcnt(0)" ::: "memory");
        } else {
            XB_SPIN(xb_ld(&bar[XB_XGEN(b.x)]) == gen, bar);
            __builtin_amdgcn_fence(__ATOMIC_ACQUIRE, "agent");
            asm volatile("s_waitcnt vmcnt(0)" ::: "memory");
        }
    }
    __syncthreads();
}

constexpr int NPHASE = 19;
constexpr int LDS_BAR = 135168, LDS_BYTES = 135184;
__device__ __forceinline__ void run_phase(const Params& p, PG8_LAS unsigned char* lds, int ph) {
    bf16_t* W = (bf16_t*)(p.ws + WS_W);
    u64* sumsq = (u64*)(p.ws + WS_SS);
    bf16_t* R1 = (bf16_t*)(p.ws + WS_R1); bf16_t* RA = (bf16_t*)(p.ws + WS_A); bf16_t* OB = (bf16_t*)p.out;
    switch (ph) {
    case 0: phase_prep(p, lds); break;
    case 1: case 8: { EpiScale<0> E; E.O = RA; E.ldc = ph == 1 ? N_AB : N_GLA; E.sumsq = sumsq + (ph == 1 ? 0 : 2 * MTOK);
        run_gemm(lds, R1, W + (ph == 1 ? WO_ABIN : WO_GLAIN), ph == 1 ? N_AB : N_GLA, 1024, E); } break;
    case 2: for (int pass = 0; pass < 2; ++pass) { if (((pass ^ (int)blockIdx.x) & 1) == 0) mix_a_phase<false>(p, lds, 2048, 0); else rg_phase<false>(p, lds); } break;
    case 3: state_scan<128, false>(p, (const float*)(p.ws + WS_MISC + MO_DECAY), 0, 64, lds); rg_carry(p); break;
    case 4: for (int pass = 0; pass < 2; ++pass) { if (((pass ^ (int)blockIdx.x) & 1) == 0) mix_c_phase<false>(p, lds, 2048, 0); else rg_phase<true>(p, lds); } break;
    case 5: { EpiResid<true> E; E.Xin = p.in[0]; E.H = R1; E.sumsq = sumsq + 1 * MTOK; run_gemm(lds, OB, W + WO_ABOUT, 1024, 1024, E); } break;
    case 7: case 15: case 17: { EpiResid<false> E; E.Xin = nullptr; E.H = R1; E.sumsq = sumsq + (ph == 7 ? 2 : ph == 15 ? 3 : 4) * MTOK;
        run_gemm(lds, ph == 15 ? OB : RA, W + (ph == 7 ? WO_W2_0 : ph == 15 ? WO_GLAOUT : WO_W2_1), 1024, ph == 15 ? 1024 : 4096, E); } break;
    case 6: case 16: { EpiScale<1> E; E.O = RA; E.ldc = DFF; E.sumsq = sumsq + (ph == 6 ? 1 : 3) * MTOK;
        run_gemm(lds, R1, W + (ph == 6 ? WO_W1_0 : WO_W1_1), DFF, 1024, E); } break;
    case 9: mix_a_phase<true>(p, lds, 1024, 0); break;
    case 10: for (int pass = 0; pass < 2; ++pass) { if (((pass ^ (int)blockIdx.x) & 1) == 0) state_scan<256, true>(p, (const float*)(p.ws + WS_MISC + MO_DECAY), 0, 32, lds); else mix_a_phase<true>(p, lds, 1024, 1); } break;
    case 11: for (int pass = 0; pass < 2; ++pass) { if (((pass ^ (int)blockIdx.x) & 1) == 0) mix_c_phase<true>(p, lds, 1024, 0); else state_scan<256, true>(p, (const float*)(p.ws + WS_MISC + MO_DECAY), 32, 32, lds); } break;
    case 12: mix_c_phase<true>(p, lds, 1024, 1); break;
    case 18: phase_final(p); break;
    }
}
#if MULTI
template <int PH> __global__ void __launch_bounds__(512, 2) k_phase(Params p) {
    extern __shared__ __attribute__((aligned(16))) unsigned char shm[];
    run_phase(p, (PG8_LAS unsigned char*)shm, PH);
}
#else
__global__ void __launch_bounds__(512, 2) k_mega(Params p) {
    extern __shared__ __attribute__((aligned(16))) unsigned char shm[];
    cg::grid_group grid = cg::this_grid();
#ifdef ONLY_PH
    run_phase(p, (PG8_LAS unsigned char*)shm, ONLY_PH);
#else
#define PH_(n) { const Params q = load_params(); run_phase(q, (PG8_LAS unsigned char*)shm, n); \
        XcdBarrier xb; xb.bar = (unsigned*)(q.ws + WS_MISC + MO_BAR); xb.x = xb_xcc_id(); xb.st = st; xcd_barrier(xb); }
    volatile LAS unsigned* st = (volatile LAS unsigned*)((PG8_LAS unsigned char*)shm + LDS_BAR);
    if (threadIdx.x == 0) { st[0] = 0u; st[1] = 0u; }
    __syncthreads();
    { const Params q = load_params();
      if (q.ws == nullptr) grid.sync();
      (void)xcd_barrier_post((unsigned*)(q.ws + WS_MISC + MO_BAR), st); }
    PH_(0) PH_(1) PH_(2) PH_(3) PH_(4) PH_(5) PH_(6) PH_(7) PH_(8) PH_(9) PH_(10) PH_(11) PH_(12) PH_(15) PH_(16) PH_(17)
    { const Params q = load_params(); run_phase(q, (PG8_LAS unsigned char*)shm, 18); }
#endif
}
#endif

extern "C" void kernel_launch(void* const* d_in, const int* in_sizes, int n_in, void* d_out, int out_size, void* d_ws, size_t ws_size, hipStream_t stream) {
    static int grid = 0;
    if (grid == 0) {
        if (n_in != 22 || ws_size < WS_END) { fprintf(stderr, "kernel_launch: unexpected n_in %d / ws_size %zu (need %zu)\n", n_in, ws_size, (size_t)WS_END); }
        int dev = 0, cus = 0, per_cu = 0;
        hipGetDevice(&dev); hipDeviceGetAttribute(&cus, hipDeviceAttributeMultiprocessorCount, dev);
#if MULTI
#define SA_(n) hipFuncSetAttribute((const void*)k_phase<n>, hipFuncAttributeMaxDynamicSharedMemorySize, LDS_BYTES);
        SA_(0) SA_(1) SA_(2) SA_(3) SA_(4) SA_(5) SA_(6) SA_(7) SA_(8) SA_(9) SA_(10) SA_(11) SA_(12) SA_(13) SA_(14) SA_(15) SA_(16) SA_(17) SA_(18)
        per_cu = 1;
#else
        hipFuncSetAttribute((const void*)k_mega, hipFuncAttributeMaxDynamicSharedMemorySize, LDS_BYTES);
        hipOccupancyMaxActiveBlocksPerMultiprocessor(&per_cu, (const void*)k_mega, 512, LDS_BYTES);
#endif
        if (per_cu < 1) { fprintf(stderr, "kernel_launch: occupancy query says %d blocks per CU\n", per_cu); per_cu = 1; }
        if (per_cu > 1) per_cu = 1;
        grid = cus * per_cu;
    }
    Params p{};
    for (int i = 0; i < 22; ++i) p.in[i] = (const float*)d_in[i];
    p.out = (float*)d_out; p.ws = (unsigned char*)d_ws;
#if MULTI
#define LP_(n) k_phase<n><<<dim3(grid), dim3(512), LDS_BYTES, stream>>>(p);
    LP_(0) LP_(1) LP_(2) LP_(3) LP_(4) LP_(5) LP_(6) LP_(7) LP_(8) LP_(9) LP_(10) LP_(11) LP_(12) LP_(13) LP_(14) LP_(15) LP_(16) LP_(17) LP_(18)
#else
    (void)hipMemsetAsync((unsigned char*)d_ws + WS_MISC + MO_BAR, 0, XCD_BAR_WORDS * sizeof(unsigned), stream);
    void* args[] = {&p};
    hipError_t e = hipLaunchCooperativeKernel((const void*)k_mega, dim3(grid), dim3(512), args, LDS_BYTES, stream);
    if (e != hipSuccess) fprintf(stderr, "cooperative launch failed: %s (grid %d)\n", hipGetErrorString(e), grid);
#endif
}
```

```cpp
#include <hip/hip_runtime.h>
#include <hip/hip_cooperative_groups.h>
#include <cstdio>
namespace cg = cooperative_groups;

#ifndef MULTI
#define MULTI 0
#endif

#define PG8_LAS __attribute__((address_space(3)))
typedef unsigned short bf16_t;
typedef short bf16x8 __attribute__((ext_vector_type(8)));
typedef float f32x4 __attribute__((ext_vector_type(4)));
typedef unsigned u32x4 __attribute__((ext_vector_type(4)));
typedef unsigned u32x2 __attribute__((ext_vector_type(2)));

__device__ __forceinline__ int ltid() { int t = threadIdx.x; asm volatile("" : "+v"(t)); return t; }
namespace pg8 {
constexpr int BM = 256, BK = 64, HALF = 128, HTB = HALF * BK * 2, STAGE_BYTES = 8 * HTB, NXCD = 8, WGM = 4;
__host__ __device__ __forceinline__ int lds_byte(int r, int c) { const int st = (r >> 4) * 2 + (c >> 5), rr = r & 15, cc = c & 31, ob = rr * 64 + cc * 2; return st * 1024 + (ob ^ (((ob >> 9) & 1) << 5)); }
__host__ __device__ __forceinline__ void stage_rc(int b, int& R, int& C) { const int st = b / 1024, sb = b % 1024, swz = sb ^ (((sb >> 9) & 1) << 5); R = (st >> 1) * 16 + swz / 64; C = (st & 1) * 32 + (swz % 64) / 2; }
__host__ __device__ __forceinline__ int perm32(int rho) { const int n = rho >> 4, i = rho & 15; return 8 * (i >> 2) + 4 * n + (i & 3); }
struct Unit { int pm, pn; };
struct Gemm { const bf16_t* A; const bf16_t* Bt; int M, N, K; };
struct StaticOrder {
    int nM, nN, nwg, G, c;
    __host__ __device__ void init(int M, int N, int G_, int c_) { nM = M / BM; nN = N / BM; nwg = nM * nN; G = G_; c = c_; }
    __host__ __device__ bool next(int i, Unit& u) const {
        const long L = (long)i * G + c; if (L >= nwg) return false;
        int wgid = (int)L; { const int q = nwg / NXCD, r = nwg % NXCD, xcd = wgid % NXCD, off = wgid / NXCD; wgid = (xcd < r ? xcd * (q + 1) : r * (q + 1) + (xcd - r) * q) + off; }
        const int nig = WGM * nN, gid = wgid / nig, fm = gid * WGM, gsz = (nM - fm) < WGM ? (nM - fm) : WGM;
        u.pm = fm + ((wgid % nig) % gsz); u.pn = (wgid % nig) / gsz; return true;
    }
    __device__ __forceinline__ void a_ready(const Unit&) const {}
    __device__ __forceinline__ void done(const Unit&) const {}
};
typedef __bf16 bf16x2_t __attribute__((ext_vector_type(2)));
typedef float f32x2_t __attribute__((ext_vector_type(2)));
__device__ __forceinline__ unsigned cvt_pk_bf16(float lo, float hi) { f32x2_t v = {lo, hi}; bf16x2_t r = __builtin_convertvector(v, bf16x2_t); return __builtin_bit_cast(unsigned, r); }

template <class Epi, class Sched>
__device__ __forceinline__ void gemm_phase(PG8_LAS unsigned char* lds, const Gemm g, const Sched& S, const Epi& E) {
    const int tid = ltid(), wid = __builtin_amdgcn_readfirstlane(tid >> 6), lane = tid & 63, wr = wid >> 2, wc = wid & 3, fr = lane & 15, fq = lane >> 4;
    const int K = g.K, nt = K / BK;
    unsigned voffA[2], voffB[2];
#pragma unroll
    for (int i = 0; i < 2; ++i) { int R, C; stage_rc(tid * 16 + i * 8192, R, C); const int Rb = Epi::PERM ? ((R & ~31) + perm32(R & 31)) : R;
        voffA[i] = (unsigned)(R * K + C) * 2u; voffB[i] = (unsigned)(Rb * K + C) * 2u; }
    const size_t kstep = (size_t)(BK * 2);
    const size_t hstep = (size_t)HALF * K * 2;
    const size_t tstep = 2 * hstep;
    const unsigned ldsw = (unsigned)wid * 1024u;
    const int aoff = lds_byte(wr * 64 + fr, fq * 8), boff = lds_byte(wc * 32 + fr, fq * 8);
#define PG8_SA(b, h) (((b) * 2 + (h)) * HTB)
#define PG8_SB(b, h) ((4 + (b) * 2 + (h)) * HTB)
#define PG8_STAGE(bufoff, gbase, voff) do { _Pragma("unroll") for (int _i = 0; _i < 2; ++_i) \
        __builtin_amdgcn_global_load_lds((const unsigned*)((const char*)(gbase) + (voff)[_i]), (PG8_LAS unsigned*)(lds + (bufoff) + ldsw + _i * 8192), 16, 0, 0); } while (0)
#define PG8_LDA(dst, b, h) do { _Pragma("unroll") for (int m = 0; m < 4; ++m) _Pragma("unroll") for (int k = 0; k < 2; ++k) dst[m][k] = *(const PG8_LAS bf16x8*)(lds + PG8_SA(b, h) + aoff + m * 2048 + k * 1024); } while (0)
#define PG8_LDB(dst, b, h) do { _Pragma("unroll") for (int n = 0; n < 2; ++n) _Pragma("unroll") for (int k = 0; k < 2; ++k) dst[n][k] = *(const PG8_LAS bf16x8*)(lds + PG8_SB(b, h) + boff + n * 2048 + k * 1024); } while (0)
#define PG8_MMA(ai, bj, At, Bt) do { __builtin_amdgcn_s_setprio(1); _Pragma("unroll") for (int m = 0; m < 4; ++m) _Pragma("unroll") for (int n = 0; n < 2; ++n) _Pragma("unroll") for (int k = 0; k < 2; ++k) \
        acc[ai][bj][m][n] = __builtin_amdgcn_mfma_f32_16x16x32_bf16(Bt[n][k], At[m][k], acc[ai][bj][m][n], 0, 0, 0); __builtin_amdgcn_s_setprio(0); } while (0)
#define PG8_WAIT_V(n) asm volatile("s_waitcnt vmcnt(" #n ")" ::: "memory")
#define PG8_WAIT_L(n) asm volatile("s_waitcnt lgkmcnt(" #n ")" ::: "memory")
#define PG8_BAR __builtin_amdgcn_s_barrier()
#define PG8_SCHED __builtin_amdgcn_sched_barrier(0)
    Unit cur, nxt; int ui = 0;
    if (!S.next(0, cur)) return;
    f32x4 acc[2][2][4][2];
#pragma unroll
    for (int a = 0; a < 2; ++a)
#pragma unroll
        for (int b = 0; b < 2; ++b)
#pragma unroll
            for (int m = 0; m < 4; ++m)
#pragma unroll
                for (int n = 0; n < 2; ++n) acc[a][b][m][n] = (f32x4){0.f, 0.f, 0.f, 0.f};
    bf16x8 At[4][2], B0[2][2], B1[2][2];
    const char* cA = (const char*)g.A + (size_t)cur.pm * tstep; const char* cB = (const char*)g.Bt + (size_t)cur.pn * tstep;
    S.a_ready(cur);
    PG8_STAGE(PG8_SB(0, 0), cB, voffB); PG8_STAGE(PG8_SA(0, 0), cA, voffA); PG8_STAGE(PG8_SB(0, 1), cB + hstep, voffB); PG8_STAGE(PG8_SA(0, 1), cA + hstep, voffA);
    if (wr == 1) PG8_BAR;
    PG8_WAIT_V(4); PG8_BAR;
    PG8_STAGE(PG8_SB(1, 0), cB + kstep, voffB); PG8_STAGE(PG8_SA(1, 0), cA + kstep, voffA); PG8_STAGE(PG8_SB(1, 1), cB + hstep + kstep, voffB);
    PG8_WAIT_V(6); PG8_BAR;
    for (;;) {
        const bool has_next = S.next(ui + 1, nxt);
        const char* nA = has_next ? (const char*)g.A + (size_t)nxt.pm * tstep : cA; const char* nB = has_next ? (const char*)g.Bt + (size_t)nxt.pn * tstep : cB;
        for (int t = 0; t < nt; t += 2) {
            const bool last = (t == nt - 2);
            const char* a1 = cA + (size_t)(t + 1) * kstep;
            const char* a2 = last ? nA : cA + (size_t)(t + 2) * kstep; const char* b2 = last ? nB : cB + (size_t)(t + 2) * kstep;
            const char* a3 = a2 + kstep; const char* b3 = b2 + kstep;
            if (last && has_next) S.a_ready(nxt);
            PG8_LDB(B0, 0, 0); PG8_SCHED; PG8_LDA(At, 0, 0); PG8_STAGE(PG8_SA(1, 1), a1 + hstep, voffA);
            PG8_WAIT_L(8); PG8_BAR; PG8_WAIT_L(0); PG8_MMA(0, 0, At, B0); PG8_BAR; PG8_SCHED;
            PG8_LDB(B1, 0, 1); PG8_STAGE(PG8_SB(0, 0), b2, voffB);
            PG8_BAR; PG8_WAIT_L(0); PG8_MMA(0, 1, At, B1); PG8_BAR;
            PG8_LDA(At, 0, 1); PG8_STAGE(PG8_SA(0, 0), a2, voffA);
            PG8_BAR; PG8_WAIT_L(0); PG8_MMA(1, 0, At, B0); PG8_BAR; PG8_SCHED;
            PG8_STAGE(PG8_SB(0, 1), b2 + hstep, voffB);
            PG8_WAIT_V(6); PG8_BAR; PG8_MMA(1, 1, At, B1); PG8_BAR;
            PG8_LDB(B0, 1, 0); PG8_SCHED; PG8_LDA(At, 1, 0); PG8_STAGE(PG8_SA(0, 1), a2 + hstep, voffA);
            PG8_WAIT_L(8); PG8_BAR; PG8_WAIT_L(0); PG8_MMA(0, 0, At, B0); PG8_BAR; PG8_SCHED;
            PG8_LDB(B1, 1, 1); PG8_STAGE(PG8_SB(1, 0), b3, voffB);
            PG8_BAR; PG8_WAIT_L(0); PG8_MMA(0, 1, At, B1); PG8_BAR;
            PG8_LDA(At, 1, 1); PG8_STAGE(PG8_SA(1, 0), a3, voffA);
            PG8_BAR; PG8_WAIT_L(0); PG8_MMA(1, 0, At, B0); PG8_BAR; PG8_SCHED;
            PG8_STAGE(PG8_SB(1, 1), b3 + hstep, voffB);
            PG8_WAIT_V(6); PG8_BAR; PG8_MMA(1, 1, At, B1); PG8_BAR;
        }
        if constexpr (!Epi::AFTER_DRAIN) { E(acc, cur, wr, wc, fr, fq); S.done(cur); }
        if (!has_next) break;
#pragma unroll
        for (int a = 0; a < 2; ++a)
#pragma unroll
            for (int b = 0; b < 2; ++b)
#pragma unroll
                for (int m = 0; m < 4; ++m)
#pragma unroll
                    for (int n = 0; n < 2; ++n) acc[a][b][m][n] = (f32x4){0.f, 0.f, 0.f, 0.f};
        cur = nxt; cA = nA; cB = nB; ++ui;
    }
    PG8_WAIT_V(0);
    if (wr == 0) PG8_BAR;
    PG8_BAR;
    if constexpr (Epi::AFTER_DRAIN) { E.fused(acc, cur, wr, wc, fr, fq, lds, wid, lane); S.done(cur); }
#undef PG8_SA
#undef PG8_SB
#undef PG8_STAGE
#undef PG8_LDA
#undef PG8_LDB
#undef PG8_MMA
#undef PG8_WAIT_V
#undef PG8_WAIT_L
#undef PG8_BAR
#undef PG8_SCHED
}
}
using pg8::cvt_pk_bf16;

constexpr int MTOK = 32768, DM = 1024, SEQ = 4096, NB = 8, NCH = 64;
constexpr int N_AB = 3584, N_GLA = 3328  , N_GLA_SRC = 3104, DFF = 4096;
constexpr float EPS = 1e-6f;
constexpr size_t WO_ABIN = 0, WO_ABOUT = WO_ABIN + (size_t)N_AB * 1024, WO_W1_0 = WO_ABOUT + 1024 * 1024, WO_W2_0 = WO_W1_0 + 4096 * 1024,
                 WO_GLAIN = WO_W2_0 + 4096 * 1024, WO_GLAOUT = WO_GLAIN + (size_t)N_GLA * 1024, WO_W1_1 = WO_GLAOUT + 1024 * 1024, WO_W2_1 = WO_W1_1 + 4096 * 1024,
                 WO_END = WO_W2_1 + 4096 * 1024;
constexpr size_t MiB = 1048576;
constexpr size_t WS_W = 0, WS_MISC = 50 * MiB, WS_R1 = 58 * MiB, WS_A = 122 * MiB, WS_ST = WS_A + 224 * MiB, WS_HB = WS_A + 288 * MiB, WS_STG = WS_A + 208 * MiB, WS_SS = 510 * MiB, WS_END = 512 * MiB;
static_assert(WO_END * 2 <= 50 * MiB, "weights region");
constexpr size_t MO_SUMSQ = 0, MO_LBV = 655360, MO_SPL = 657408, MO_RGW = 1 * MiB, MO_RGA = 2 * MiB, MO_RGH = 4 * MiB, MO_DECAY = 6 * MiB, MO_WUPT = 786432, MO_BAR = 851968;

typedef unsigned long long u64;
constexpr float SS_SCALE = 16777216.0f, SS_INV = 1.0f / (16777216.0f * 1024.0f);
struct Params {
    const float* in[22];
    float* out;
    unsigned char* ws;
};

__device__ __forceinline__ Params load_params() {
#if defined(__HIP_DEVICE_COMPILE__)
    auto q = __builtin_amdgcn_kernarg_segment_ptr();
    asm volatile("" : "+s"(q));
    return *(const __attribute__((address_space(4))) Params*)q;
#else
    return Params{};
#endif
}
__device__ __forceinline__ float bf2f(bf16_t b) { return __uint_as_float(((unsigned)b) << 16); }
__device__ __forceinline__ bf16_t f2bf(float f) { unsigned u = __float_as_uint(f); u += 0x7FFFu + ((u >> 16) & 1u); return (bf16_t)(u >> 16); }
__device__ __forceinline__ float frcp(float x) { return __builtin_amdgcn_rcpf(x); }
__device__ __forceinline__ float fexp(float x) { return __builtin_amdgcn_exp2f(x * 1.4426950408889634f); }
__device__ __forceinline__ float flog(float x) { return __builtin_amdgcn_logf(x) * 0.6931471805599453f; }
__device__ __forceinline__ float sigmoidf_(float x) { return frcp(1.0f + fexp(-x)); }
__device__ __forceinline__ void unpack8(const u32x4 v, float (&f)[8]) {
#pragma unroll
    for (int i = 0; i < 4; ++i) { f[2 * i] = __uint_as_float(v[i] << 16); f[2 * i + 1] = __uint_as_float(v[i] & 0xffff0000u); }
}
__device__ __forceinline__ u32x4 pack8(const float (&f)[8]) { u32x4 r;
#pragma unroll
    for (int i = 0; i < 4; ++i) r[i] = cvt_pk_bf16(f[2 * i], f[2 * i + 1]);
    return r; }

__device__ __forceinline__ bf16_t* gla_state(const Params& p, int chain) {
    unsigned char* base = chain < 45 ? p.ws + WS_STG + (size_t)chain * (4 * MiB)
                        : chain < 61 ? (unsigned char*)p.out + 64 * MiB + (size_t)(chain - 45) * (4 * MiB)
                        : p.ws + WS_W + (size_t)(chain - 61) * (4 * MiB);
    return (bf16_t*)base;
}
template <int ACT> struct EpiScale {
    static constexpr bool PERM = true, AFTER_DRAIN = false;
    bf16_t* O; int ldc; const u64* sumsq;
    __device__ __forceinline__ void operator()(const f32x4 (&acc)[2][2][4][2], const pg8::Unit& u, int wr, int wc, int fr, int fq) const {
        const int row0 = u.pm * 256 + wr * 64 + fr, col0 = u.pn * 256 + wc * 32 + 8 * fq;
        float rs[2][4];
#pragma unroll
        for (int ai = 0; ai < 2; ++ai)
#pragma unroll
            for (int m = 0; m < 4; ++m) rs[ai][m] = (float)sumsq[row0 + ai * 128 + m * 16];
#pragma unroll
        for (int ai = 0; ai < 2; ++ai)
#pragma unroll
            for (int m = 0; m < 4; ++m) rs[ai][m] = rsqrtf(rs[ai][m] * SS_INV + EPS);
#pragma unroll
        for (int ai = 0; ai < 2; ++ai)
#pragma unroll
            for (int m = 0; m < 4; ++m) {
                const int row = row0 + ai * 128 + m * 16;
                bf16_t* rowp = O + (size_t)row * ldc + col0;
#pragma unroll
                for (int bj = 0; bj < 2; ++bj) {
                    f32x4 v0 = acc[ai][bj][m][0] * rs[ai][m], v1 = acc[ai][bj][m][1] * rs[ai][m];
                    if (ACT == 1) {
#pragma unroll
                        for (int e = 0; e < 4; ++e) { float a = fmaxf(v0[e], 0.f), b = fmaxf(v1[e], 0.f); v0[e] = a * a; v1[e] = b * b; }
                    }
                    u32x4 pk; pk[0] = cvt_pk_bf16(v0[0], v0[1]); pk[1] = cvt_pk_bf16(v0[2], v0[3]); pk[2] = cvt_pk_bf16(v1[0], v1[1]); pk[3] = cvt_pk_bf16(v1[2], v1[3]);
                    *(u32x4*)(rowp + bj * 128) = pk;
                }
            }
    }
};
template <bool XIN> struct EpiResid {
    static constexpr bool PERM = true, AFTER_DRAIN = false;
    const float* Xin; bf16_t* H; u64* sumsq;
    __device__ __forceinline__ void operator()(const f32x4 (&acc)[2][2][4][2], const pg8::Unit& u, int wr, int wc, int fr, int fq) const {
        const int row0 = u.pm * 256 + wr * 64 + fr, col0 = u.pn * 256 + wc * 32 + 8 * fq;
#pragma unroll
        for (int ai = 0; ai < 2; ++ai) {
            f32x4 hx[4][2][2]; u32x4 hb[4][2];
#pragma unroll
            for (int m = 0; m < 4; ++m)
#pragma unroll
                for (int bj = 0; bj < 2; ++bj) { const size_t ro = (size_t)(row0 + ai * 128 + m * 16) * 1024 + col0 + bj * 128;
                    if (XIN) { hx[m][bj][0] = *(const f32x4*)(Xin + ro); hx[m][bj][1] = *(const f32x4*)(Xin + ro + 4); } else hb[m][bj] = *(const u32x4*)(H + ro); }
            __builtin_amdgcn_sched_barrier(0);
#pragma unroll
            for (int m = 0; m < 4; ++m) {
                const int row = row0 + ai * 128 + m * 16;
                const size_t ro = (size_t)row * 1024 + col0;
                float ss = 0.f;
#pragma unroll
                for (int bj = 0; bj < 2; ++bj) {
                    f32x4 h0, h1;
                    if (XIN) { h0 = hx[m][bj][0]; h1 = hx[m][bj][1]; } else { float t[8]; unpack8(hb[m][bj], t); h0 = (f32x4){t[0], t[1], t[2], t[3]}; h1 = (f32x4){t[4], t[5], t[6], t[7]}; }
                    const f32x4 v0 = acc[ai][bj][m][0] + h0, v1 = acc[ai][bj][m][1] + h1;
                    u32x4 pk; pk[0] = cvt_pk_bf16(v0[0], v0[1]); pk[1] = cvt_pk_bf16(v0[2], v0[3]); pk[2] = cvt_pk_bf16(v1[0], v1[1]); pk[3] = cvt_pk_bf16(v1[2], v1[3]);
                    *(u32x4*)(H + ro + bj * 128) = pk;
#pragma unroll
                    for (int e = 0; e < 4; ++e) ss += v0[e] * v0[e] + v1[e] * v1[e];
                }
                ss += __shfl_xor(ss, 16); ss += __shfl_xor(ss, 32);
                if (fq == 0) (void)__hip_atomic_fetch_add(sumsq + row, (u64)(ss * SS_SCALE), __ATOMIC_RELAXED, __HIP_MEMORY_SCOPE_AGENT);
            }
            __builtin_amdgcn_sched_barrier(0);
        }
    }
};
template <class Epi> __device__ __forceinline__ void run_gemm(PG8_LAS unsigned char* lds, const bf16_t* A, const bf16_t* Bt, int N, int K, const Epi& E) {
    pg8::Gemm g; g.A = A; g.Bt = Bt; g.M = MTOK; g.N = N; g.K = K;
    pg8::StaticOrder S; S.init(MTOK, N, (int)gridDim.x, (int)blockIdx.x);
    pg8::gemm_phase<Epi, pg8::StaticOrder>(lds, g, S, E);
}

template <int MT, int NT, bool SWA, bool SWB, int K, class PA, class PB>
__device__ __forceinline__ void mma_tiles(f32x4 (&acc)[MT][NT], PA A, int lda, int m0, PB B, int ldb, int n0, int fr, int fq) {
#pragma unroll
    for (int k0 = 0; k0 < K; k0 += 32) {
        bf16x8 a[MT], b[NT];
#pragma unroll
        for (int mt = 0; mt < MT; ++mt) { const int row = m0 + mt * 16 + fr; int kb = (k0 >> 3) + fq; if (SWA) kb ^= (row >> 3) & 7; a[mt] = *(const bf16x8*)(A + row * lda + kb * 8); }
#pragma unroll
        for (int nt = 0; nt < NT; ++nt) { const int row = n0 + nt * 16 + fr; int kb = (k0 >> 3) + fq; if (SWB) kb ^= (row >> 3) & 7; b[nt] = *(const bf16x8*)(B + row * ldb + kb * 8); }
#pragma unroll
        for (int mt = 0; mt < MT; ++mt)
#pragma unroll
            for (int nt = 0; nt < NT; ++nt) acc[mt][nt] = __builtin_amdgcn_mfma_f32_16x16x32_bf16(b[nt], a[mt], acc[mt][nt], 0, 0, 0);
    }
}
typedef PG8_LAS float* lds_f32p;
typedef PG8_LAS bf16_t* lds_bf16p;

__device__ __forceinline__ void transpose_tile(const float* src, bf16_t* dst, const float* scale, int K, int Nsrc, int k0, int n0, lds_f32p T, int tid) {
    { const int r = tid >> 3, c = (tid & 7) * 8;
      f32x4 v0 = {0.f, 0.f, 0.f, 0.f}, v1 = v0;
      if (n0 + c < Nsrc) { const float* sp = src + (size_t)(k0 + r) * Nsrc + n0 + c; v0 = *(const f32x4*)sp; v1 = *(const f32x4*)(sp + 4); }
      const float sc = scale ? scale[k0 + r] : 1.0f;
#pragma unroll
      for (int e = 0; e < 4; ++e) { T[r * 65 + c + e] = v0[e] * sc; T[r * 65 + c + 4 + e] = v1[e] * sc; } }
    __syncthreads();
    { const int n = tid >> 3, kk = (tid & 7) * 8; float f[8];
#pragma unroll
      for (int e = 0; e < 8; ++e) f[e] = T[(kk + e) * 65 + n];
      *(u32x4*)(dst + (size_t)(n0 + n) * K + k0 + kk) = pack8(f); }
    __syncthreads();
}
__device__ void phase_prep(const Params& p, PG8_LAS unsigned char* lds) {
    const int tid = ltid(), lane = tid & 63, wid = tid >> 6;
    u64* sumsq = (u64*)(p.ws + WS_SS);
    bf16_t* xb = (bf16_t*)(p.ws + WS_R1);
    for (int row = blockIdx.x * 8 + wid; row < MTOK; row += gridDim.x * 8) {
        const float* xr = p.in[0] + (size_t)row * 1024; float ss = 0.f;
#pragma unroll
        for (int i = 0; i < 2; ++i) { const f32x4 v = *(const f32x4*)(xr + i * 512 + lane * 8), w = *(const f32x4*)(xr + i * 512 + lane * 8 + 4);
            ss += v[0] * v[0] + v[1] * v[1] + v[2] * v[2] + v[3] * v[3] + w[0] * w[0] + w[1] * w[1] + w[2] * w[2] + w[3] * w[3];
            u32x4 pk; pk[0] = cvt_pk_bf16(v[0], v[1]); pk[1] = cvt_pk_bf16(v[2], v[3]); pk[2] = cvt_pk_bf16(w[0], w[1]); pk[3] = cvt_pk_bf16(w[2], w[3]);
            *(u32x4*)(xb + (size_t)row * 1024 + i * 512 + lane * 8) = pk; }
#pragma unroll
        for (int o = 32; o >= 1; o >>= 1) ss += __shfl_xor(ss, o);
        if (lane == 0) sumsq[row] = (u64)(ss * SS_SCALE);
    }
    const int gtid = blockIdx.x * 512 + tid, gstride = gridDim.x * 512;
    for (int i = gtid; i < 4 * MTOK; i += gstride) sumsq[MTOK + i] = 0ull;
    { bf16_t* rgw = (bf16_t*)(p.ws + WS_MISC + MO_RGW);
      for (int i = gtid; i < 131072; i += gstride) { const int mat = i >> 15, kind = mat >> 1, dir = mat & 1, g = (i >> 12) & 7, j = (i >> 6) & 63, ii = i & 63;
          const float* s = kind ? p.in[12] : p.in[10]; rgw[i] = f2bf(s[((dir * 8 + g) * 64 + ii) * 64 + j]); } }
    { bf16_t* wupt = (bf16_t*)(p.ws + WS_MISC + MO_WUPT);
      for (int i = gtid; i < 16384; i += gstride) { const int dir = i >> 13, d = (i >> 4) & 511, r = i & 15; wupt[i] = f2bf(p.in[19][(size_t)(dir * 16 + r) * 512 + d]); } }
    { float* lbv = (float*)(p.ws + WS_MISC + MO_LBV); float* spl = (float*)(p.ws + WS_MISC + MO_SPL);
      for (int i = gtid; i < 512; i += gstride) { const float l0 = p.in[15][i], l1 = p.in[15][512 + i]; lbv[i] = 1.0f / (1.0f + expf(l1 - l0)); }
      for (int i = gtid; i < 1024; i += gstride) { const float lam = p.in[14][i]; spl[i] = fmaxf(-lam, 0.f) + log1pf(expf(-fabsf(lam))); } }
    bf16_t* W = (bf16_t*)(p.ws + WS_W);
    lds_f32p T = (lds_f32p)lds;
    struct TD { const float* src; bf16_t* dst; const float* scale; int K, Nsrc, k0, n0; };
    auto desc = [&](int tile) { TD d; d.scale = nullptr; d.K = 1024; int Npad, base;
        if (tile < 896) { base = 0; d.src = p.in[6]; d.dst = W + WO_ABIN; d.scale = p.in[1]; d.Nsrc = Npad = 3584; }
        else if (tile < 1152) { base = 896; d.src = p.in[7]; d.dst = W + WO_ABOUT; d.Nsrc = Npad = 1024; }
        else if (tile < 2176) { base = 1152; d.src = p.in[4]; d.dst = W + WO_W1_0; d.scale = p.in[2]; d.Nsrc = Npad = 4096; }
        else if (tile < 3200) { base = 2176; d.src = p.in[5]; d.dst = W + WO_W2_0; d.K = 4096; d.Nsrc = Npad = 1024; }
        else if (tile < 4032) { base = 3200; d.src = p.in[17]; d.dst = W + WO_GLAIN; d.scale = p.in[1] + 1024; d.Nsrc = N_GLA_SRC; Npad = N_GLA; }
        else if (tile < 4288) { base = 4032; d.src = p.in[18]; d.dst = W + WO_GLAOUT; d.Nsrc = Npad = 1024; }
        else if (tile < 5312) { base = 4288; d.src = p.in[4] + (size_t)1024 * 4096; d.dst = W + WO_W1_1; d.scale = p.in[2] + 1024; d.Nsrc = Npad = 4096; }
        else { base = 5312; d.src = p.in[5] + (size_t)4096 * 1024; d.dst = W + WO_W2_1; d.K = 4096; d.Nsrc = Npad = 1024; }
        const int local = tile - base, ntn = Npad >> 6, kti = local / ntn, nti = local - kti * ntn; d.k0 = kti * 64; d.n0 = nti * 64; return d; };
    const int r = tid >> 3, c = (tid & 7) * 8;
    auto tload = [&](const TD& d, f32x4& v0, f32x4& v1, float& sc) { v0 = (f32x4){0.f, 0.f, 0.f, 0.f}; v1 = v0;
        if (d.n0 + c < d.Nsrc) { const float* sp = d.src + (size_t)(d.k0 + r) * d.Nsrc + d.n0 + c; v0 = *(const f32x4*)sp; v1 = *(const f32x4*)(sp + 4); }
        sc = d.scale ? d.scale[d.k0 + r] : 1.0f; };
    int tile = blockIdx.x, buf = 0; TD cur = desc(tile < 6336 ? tile : 0); f32x4 v0, v1; float sc;
    if (tile < 6336) tload(cur, v0, v1, sc);
    for (; tile < 6336; tile += gridDim.x, buf ^= 1) {
        const int nt_ = tile + gridDim.x; TD nxt = desc(nt_ < 6336 ? nt_ : 0); f32x4 n0v = v0, n1v = v1; float nsc = sc;
        if (nt_ < 6336) tload(nxt, n0v, n1v, nsc);
        lds_f32p Tb = T + buf * (64 * 65);
#pragma unroll
        for (int e = 0; e < 4; ++e) { Tb[r * 65 + c + e] = v0[e] * sc; Tb[r * 65 + c + 4 + e] = v1[e] * sc; }
        __syncthreads();
        { const int n = tid >> 3, kk = (tid & 7) * 8; float f[8];
#pragma unroll
          for (int e = 0; e < 8; ++e) f[e] = Tb[(kk + e) * 65 + n];
          *(u32x4*)(cur.dst + (size_t)(cur.n0 + n) * cur.K + cur.k0 + kk) = pack8(f); }
        cur = nxt; v0 = n0v; v1 = n1v; sc = nsc;
    }
    __syncthreads();
}
__device__ void phase_final(const Params& p) {
    const int tid = ltid(), lane = tid & 63, wid = tid >> 6;
    const u64* sumsq = (const u64*)(p.ws + WS_SS) + 4 * MTOK;
    const bf16_t* H = (const bf16_t*)(p.ws + WS_R1);
    for (int row = blockIdx.x * 8 + wid; row < MTOK; row += gridDim.x * 8) {
        const float rs = rsqrtf((float)sumsq[row] * SS_INV + EPS);
        float* xr = p.out + (size_t)row * 1024;
#pragma unroll
        for (int i = 0; i < 2; ++i) { const u32x4 raw = *(const u32x4*)(H + (size_t)row * 1024 + i * 512 + lane * 8); float t[8]; unpack8(raw, t);
            const f32x4 g0 = *(const f32x4*)(p.in[3] + i * 512 + lane * 8), g1 = *(const f32x4*)(p.in[3] + i * 512 + lane * 8 + 4);
            f32x4 v0 = (f32x4){t[0], t[1], t[2], t[3]} * rs * g0, v1 = (f32x4){t[4], t[5], t[6], t[7]} * rs * g1;
            *(f32x4*)(xr + i * 512 + lane * 8) = v0; *(f32x4*)(xr + i * 512 + lane * 8 + 4) = v1; }
    }
}

__device__ __forceinline__ float gelu_tanh(float x) { const float y = 0.7978845608028654f * (x + 0.044715f * x * x * x); const float t = 1.0f - 2.0f * frcp(1.0f + fexp(2.0f * y)); return 0.5f * x * (1.0f + t); }
struct RgW { f32x4 cw[4][2], cb[2]; bf16x8 wB[2][2]; f32x4 gb[2], sp[2]; };
template <bool FINAL> struct RawR { u32x4 xr[4]; u32x4 garaw; float carry; };
__device__ __forceinline__ void rg_load_w(const Params& p, int g, RgW& W) {
    const int tid = ltid(), lane = tid & 63, wid = tid >> 6, fr = lane & 15, fq = lane >> 4;
    const int c8 = (tid & 7) * 8, ch = g * 64 + c8;
    const float* spl = (const float*)(p.ws + WS_MISC + MO_SPL);
    const bf16_t* rgw = (const bf16_t*)(p.ws + WS_MISC + MO_RGW);
#pragma unroll
    for (int w = 0; w < 4; ++w) { W.cw[w][0] = *(const f32x4*)(p.in[8] + w * 512 + ch); W.cw[w][1] = *(const f32x4*)(p.in[8] + w * 512 + ch + 4); }
    W.cb[0] = *(const f32x4*)(p.in[9] + ch); W.cb[1] = *(const f32x4*)(p.in[9] + ch + 4);
    const int mat = wid >> 1, nh = wid & 1, kind = mat >> 1, dirm = mat & 1;
#pragma unroll
    for (int nt = 0; nt < 2; ++nt) { const int col = nh * 32 + nt * 16 + fq * 4;
#pragma unroll
        for (int ks = 0; ks < 2; ++ks) W.wB[nt][ks] = *(const bf16x8*)(rgw + (size_t)(mat * 8 + g) * 4096 + (nh * 32 + nt * 16 + fr) * 64 + ks * 32 + fq * 8);
        W.gb[nt] = *(const f32x4*)((kind ? p.in[13] : p.in[11]) + dirm * 512 + g * 64 + col);
        W.sp[nt] = *(const f32x4*)(spl + dirm * 512 + g * 64 + col); }
}
template <bool FINAL> __device__ __forceinline__ void rg_load(const Params& p, int item, RawR<FINAL>& R) {
    const int tid = ltid();
    const int b = item >> 9, c = (item >> 3) & 63, g = item & 7;
    const bf16_t* proj = (const bf16_t*)(p.ws + WS_A);
    const float* RGH = (const float*)(p.ws + WS_MISC + MO_RGH);
    const int j = tid >> 3, c8 = (tid & 7) * 8, ch = g * 64 + c8;
    const size_t tok = (size_t)b * SEQ + c * 64 + j;
#pragma unroll
    for (int w = 0; w < 4; ++w) { const int tt = c * 64 + j + w - 2; R.xr[w] = (u32x4){0u, 0u, 0u, 0u};
        if (tt >= 0 && tt < SEQ) R.xr[w] = *(const u32x4*)(proj + (size_t)(b * SEQ + tt) * N_AB + ch); }
    const int dc = tid & 127, sdir = dc >> 6, sch = dc & 63;
    const size_t so = ((size_t)(b * 2 + sdir) * 64 + c) * 512 + g * 64 + sch;
    R.carry = 0.f; R.garaw = (u32x4){0u, 0u, 0u, 0u};
    if (FINAL) { R.carry = RGH[so]; R.garaw = *(const u32x4*)(proj + tok * N_AB + 512 + ch); }
}
template <bool FINAL> __device__ __forceinline__ void rg_compute(const Params& p, PG8_LAS unsigned char* lds, int item, const RawR<FINAL>& R, const RgW& W) {
    const int tid = ltid(), lane = tid & 63, wid = tid >> 6, fr = lane & 15, fq = lane >> 4;
    const int b = item >> 9, c = (item >> 3) & 63, g = item & 7;
    lds_f32p xc = (lds_f32p)lds; lds_bf16p xcb = (lds_bf16p)(lds + 16384); lds_f32p LA = (lds_f32p)(lds + 25600); lds_f32p LI = (lds_f32p)(lds + 58368);
    lds_f32p SEGP = (lds_f32p)(lds + 91136); lds_f32p SEGH = (lds_f32p)(lds + 93184);
    float* RGA = (float*)(p.ws + WS_MISC + MO_RGA); float* RGH = (float*)(p.ws + WS_MISC + MO_RGH);
    const int j = tid >> 3, c8 = (tid & 7) * 8, ch = g * 64 + c8;
    const size_t tok = (size_t)b * SEQ + c * 64 + j;
    const int mat = wid >> 1, nh = wid & 1, kind = mat >> 1, dirm = mat & 1;
    const int seg = tid >> 7, dc = tid & 127, sdir = dc >> 6, sch = dc & 63;
    const size_t so = ((size_t)(b * 2 + sdir) * 64 + c) * 512 + g * 64 + sch;
    const float carry = R.carry; const u32x4 garaw = R.garaw;
    { float a[8];
#pragma unroll
      for (int e = 0; e < 4; ++e) { a[e] = W.cb[0][e]; a[4 + e] = W.cb[1][e]; }
#pragma unroll
      for (int w = 0; w < 4; ++w) { float x[8]; unpack8(R.xr[w], x);
#pragma unroll
          for (int e = 0; e < 4; ++e) { a[e] += W.cw[w][0][e] * x[e]; a[4 + e] += W.cw[w][1][e] * x[4 + e]; } }
      f32x4 o0, o1;
#pragma unroll
      for (int e = 0; e < 4; ++e) { o0[e] = a[e]; o1[e] = a[4 + e]; }
      *(PG8_LAS f32x4*)(xc + j * 64 + c8) = o0; *(PG8_LAS f32x4*)(xc + j * 64 + c8 + 4) = o1;
      *(PG8_LAS u32x4*)(xcb + j * 72 + c8) = pack8(a); }
    __syncthreads();
    { f32x4 acc[4][2];
#pragma unroll
      for (int mt = 0; mt < 4; ++mt)
#pragma unroll
          for (int nt = 0; nt < 2; ++nt) acc[mt][nt] = (f32x4){0.f, 0.f, 0.f, 0.f};
#pragma unroll
      for (int ks = 0; ks < 2; ++ks) { bf16x8 a[4];
#pragma unroll
          for (int mt = 0; mt < 4; ++mt) a[mt] = *(PG8_LAS const bf16x8*)(xcb + (mt * 16 + fr) * 72 + ks * 32 + fq * 8);
#pragma unroll
          for (int mt = 0; mt < 4; ++mt)
#pragma unroll
              for (int nt = 0; nt < 2; ++nt) acc[mt][nt] = __builtin_amdgcn_mfma_f32_16x16x32_bf16(W.wB[nt][ks], a[mt], acc[mt][nt], 0, 0, 0); }
      lds_f32p dstp = (kind ? LI : LA) + dirm * 4096;
#pragma unroll
      for (int nt = 0; nt < 2; ++nt) { const int col = nh * 32 + nt * 16 + fq * 4;
#pragma unroll
          for (int mt = 0; mt < 4; ++mt) { const int row = mt * 16 + fr; f32x4 v;
#pragma unroll
              for (int e = 0; e < 4; ++e) { const float sg = sigmoidf_(acc[mt][nt][e] + W.gb[nt][e]); v[e] = kind ? sg : -8.0f * sg * W.sp[nt][e]; }
              *(PG8_LAS f32x4*)(dstp + row * 64 + col) = v; } } }
    __syncthreads();
#pragma unroll
    for (int i = 0; i < 4; ++i) { const int vi = tid + 512 * i, dir = vi >> 10, jj = (vi >> 4) & 63, c4 = (vi & 15) * 4;
        const f32x4 la = *(PG8_LAS f32x4*)(LA + dir * 4096 + jj * 64 + c4), ig = *(PG8_LAS f32x4*)(LI + dir * 4096 + jj * 64 + c4), x = *(PG8_LAS f32x4*)(xc + jj * 64 + c4);
        f32x4 a, u;
#pragma unroll
        for (int e = 0; e < 4; ++e) { a[e] = fexp(la[e]);
            const float x2 = 2.0f * la[e]; const float om = x2 > -0.3f ? -x2 * (1.0f + x2 * (0.5f + x2 * (0.16666667f + x2 * (0.041666668f + x2 * 0.0083333338f)))) : 1.0f - a[e] * a[e];
            u[e] = __builtin_amdgcn_sqrtf(fmaxf(om, 0.f)) * ig[e] * x[e]; }
        *(PG8_LAS f32x4*)(LA + dir * 4096 + jj * 64 + c4) = a; *(PG8_LAS f32x4*)(LI + dir * 4096 + jj * 64 + c4) = u; }
    __syncthreads();
    { float a[16], u[16]; float hl = 0.f, Pl = 1.f;
#pragma unroll
      for (int e = 0; e < 16; ++e) { const int jj = seg * 16 + e, jr = sdir ? 63 - jj : jj; a[e] = LA[sdir * 4096 + jr * 64 + sch]; u[e] = LI[sdir * 4096 + jr * 64 + sch]; }
#pragma unroll
      for (int e = 0; e < 16; ++e) { hl = a[e] * hl + u[e]; Pl *= a[e]; }
      SEGP[seg * 128 + dc] = Pl; SEGH[seg * 128 + dc] = hl;
      __syncthreads();
      float H = carry, Pt = 1.f;
#pragma unroll
      for (int s = 0; s < 3; ++s) { const float ps = SEGP[s * 128 + dc], hs = SEGH[s * 128 + dc]; if (s < seg) { H = ps * H + hs; Pt *= ps; } }
      if (FINAL) {
#pragma unroll
          for (int e = 0; e < 16; ++e) { const int jj = seg * 16 + e, jr = sdir ? 63 - jj : jj; H = a[e] * H + u[e]; LI[sdir * 4096 + jr * 64 + sch] = H; }
      } else if (seg == 3) { RGA[so] = Pt * Pl; RGH[so] = Pl * H + hl; } }
    if (FINAL) {
        __syncthreads();
        float ga[8], o[8]; unpack8(garaw, ga);
#pragma unroll
        for (int e = 0; e < 8; ++e) o[e] = (LI[j * 64 + c8 + e] + LI[4096 + j * 64 + c8 + e]) * gelu_tanh(ga[e]);
        *(u32x4*)((bf16_t*)p.out + tok * 1024 + ch) = pack8(o);
    }
    __syncthreads();
}
__device__ void rg_carry(const Params& p) {
    float* RGA = (float*)(p.ws + WS_MISC + MO_RGA); float* RGH = (float*)(p.ws + WS_MISC + MO_RGH);
    const int idx = blockIdx.x * 512 + ltid();
    if (idx < 8192) { const int bd = idx >> 9, dir = bd & 1, ch = idx & 511; const size_t base = (size_t)bd * 64 * 512 + ch; float H = 0.f;
        for (int cb = 0; cb < 64; cb += 8) { float a[8], he[8];
#pragma unroll
            for (int e = 0; e < 8; ++e) { const int c = dir ? 63 - (cb + e) : cb + e; a[e] = RGA[base + c * 512]; he[e] = RGH[base + c * 512]; }
#pragma unroll
            for (int e = 0; e < 8; ++e) { const int c = dir ? 63 - (cb + e) : cb + e; RGH[base + c * 512] = H; H = a[e] * H + he[e]; } } }
}

constexpr int LDS_SEGT = 131072, LDS_RED = 133120;
__device__ __forceinline__ void hg_gate(const u32x4 raw, const float (&lb)[8], float (&lf)[8], float (&k)[8]) {
    float x[8]; unpack8(raw, x);
#pragma unroll
    for (int e = 0; e < 8; ++e) { const float ex = fexp(-x[e]), sg = frcp(1.0f + ex); lf[e] = flog(lb[e] + (1.0f - lb[e]) * sg); k[e] = (1.0f - lb[e]) * ex * sg; }
}
__device__ __forceinline__ void gla_gate(const bf16x8 wB, const bf16x8 (&lrA)[4], const f32x4 bias, lds_f32p cum, int wid, int fr, int fq) {
#pragma unroll
    for (int mt = 0; mt < 4; ++mt) { f32x4 z = __builtin_amdgcn_mfma_f32_16x16x32_bf16(wB, lrA[mt], (f32x4){0.f, 0.f, 0.f, 0.f}, 0, 0, 0);
#pragma unroll
        for (int e = 0; e < 4; ++e) { const float zz = z[e] + bias[e]; z[e] = (fminf(zz, 0.f) - flog(1.0f + fexp(-fabsf(zz)))) * (1.0f / 16.0f); }
        *(PG8_LAS f32x4*)(cum + (mt * 16 + fr) * 128 + wid * 16 + fq * 4) = z; }
}
__device__ __forceinline__ void chunk_scan(lds_f32p cum, lds_f32p segt, int dir, int tid) {
    const int seg = tid >> 7, d = tid & 127; float v[16], run = 0.f;
#pragma unroll
    for (int e = 0; e < 16; ++e) { const int jj = seg * 16 + e, j = dir ? 63 - jj : jj; v[e] = cum[j * 128 + d]; }
#pragma unroll
    for (int e = 0; e < 16; ++e) { run += v[e]; v[e] = run; }
    segt[seg * 128 + d] = run;
    __syncthreads();
    float off = 0.f;
#pragma unroll
    for (int s = 0; s < 3; ++s) { const float t = segt[s * 128 + d]; if (s < seg) off += t; }
#pragma unroll
    for (int e = 0; e < 16; ++e) { const int jj = seg * 16 + e, j = dir ? 63 - jj : jj; cum[j * 128 + d] = v[e] + off; }
}
typedef short s16x4 __attribute__((ext_vector_type(4)));
__device__ __forceinline__ bf16x8 frag_tr(PG8_LAS const bf16_t* img, int ld, int k0, int n0, int lane) {
    const int g = lane >> 4, q = (lane & 15) >> 2, pp = lane & 3;
    PG8_LAS const bf16_t* a0 = img + (k0 + 8 * g + q) * ld + n0 + 4 * pp;
    const s16x4 lo = __builtin_amdgcn_ds_read_tr16_b64_v4i16((PG8_LAS s16x4*)a0);
    const s16x4 hi = __builtin_amdgcn_ds_read_tr16_b64_v4i16((PG8_LAS s16x4*)(a0 + 4 * ld));
    return (bf16x8){lo[0], lo[1], lo[2], lo[3], hi[0], hi[1], hi[2], hi[3]};
}
__device__ __forceinline__ bf16x8 frag_tr_perm(PG8_LAS const bf16_t* img, int ld, int k0, int nb, int off, int lane) {
    const int g = lane >> 4, q = (lane & 15) >> 2, pp = lane & 3;
    PG8_LAS const bf16_t* a0 = img + (k0 + 8 * g + q) * ld + nb + 8 * pp + off;
    const s16x4 lo = __builtin_amdgcn_ds_read_tr16_b64_v4i16((PG8_LAS s16x4*)a0);
    const s16x4 hi = __builtin_amdgcn_ds_read_tr16_b64_v4i16((PG8_LAS s16x4*)(a0 + 4 * ld));
    return (bf16x8){lo[0], lo[1], lo[2], lo[3], hi[0], hi[1], hi[2], hi[3]};
}
template <int DV> __device__ __forceinline__ void store_v(const u32x4 (&vraw)[DV / 64], lds_bf16p V, int tid) {
    constexpr int G8 = DV / 8;
#pragma unroll
    for (int i = 0; i < DV / 64; ++i) { const int idx = tid + 512 * i, j = idx / G8, c8 = (idx % G8) * 8; *(PG8_LAS u32x4*)(V + j * (DV + 16) + c8) = vraw[i]; }
}
template <bool GLA> struct RawA { u32x4 v[GLA ? 4 : 2]; u32x4 k[GLA ? 2 : 4]; };
template <bool GLA> __device__ __forceinline__ void mix_a_load(const Params& p, int it, int half, RawA<GLA>& R) {
    constexpr int DV = GLA ? 256 : 128, G8 = DV / 8;
    const int c = it & 63, h = (it >> 6) & 3, bl = it >> 8, b = half * 4 + bl;
    const int tid = ltid(), lane = tid & 63, wid = tid >> 6, fr = lane & 15, fq = lane >> 4;
    const size_t tok0 = (size_t)b * SEQ + c * 64;
    const bf16_t* proj = (const bf16_t*)(p.ws + WS_A);
    const int d8 = (tid & 15) * 8, jb = tid >> 4;
#pragma unroll
    for (int i = 0; i < DV / 64; ++i) { const int idx = tid + 512 * i, j = idx / G8, c8 = (idx % G8) * 8;
        R.v[i] = *(const u32x4*)(GLA ? proj + (tok0 + j) * N_GLA + 1024 + h * 256 + c8 : proj + (tok0 + j) * N_AB + 2560 + h * 128 + c8); }
#pragma unroll
    for (int i = 0; i < 2; ++i) { const int j = jb + 32 * i;
        if (GLA) R.k[i] = *(const u32x4*)(proj + (tok0 + j) * N_GLA + 512 + h * 128 + d8);
        else { const bf16_t* rp = proj + (tok0 + j) * N_AB + 1536 + h * 128 + d8; R.k[i] = *(const u32x4*)rp; R.k[GLA ? 0 : 2 + i] = *(const u32x4*)(rp + 512); } }
}
template <bool GLA> __device__ __forceinline__ void mix_a_compute(const Params& p, PG8_LAS unsigned char* lds, int it, int half, const RawA<GLA>& R) {
    constexpr int DV = GLA ? 256 : 128;
    const int c = it & 63, h = (it >> 6) & 3, bl = it >> 8;
    const int tid = ltid(), lane = tid & 63, wid = tid >> 6, fr = lane & 15, fq = lane >> 4;
    lds_f32p cum = (lds_f32p)lds; lds_bf16p ksT = (lds_bf16p)(lds + 32768); lds_bf16p vT = (lds_bf16p)(lds + 51200); lds_f32p segt = (lds_f32p)(lds + LDS_SEGT);
    const int d8 = (tid & 15) * 8, jb = tid >> 4;
    bf16x8 lrA[4], wB[2]; f32x4 bias[2];
    if (GLA) { const bf16_t* proj = (const bf16_t*)(p.ws + WS_A); const size_t tok0 = (size_t)(half * 4 + bl) * SEQ + c * 64;
#pragma unroll
        for (int mt = 0; mt < 4; ++mt) lrA[mt] = *(const bf16x8*)(proj + (tok0 + mt * 16 + fr) * N_GLA + 3072 + fq * 8);
#pragma unroll
        for (int dir = 0; dir < 2; ++dir) { wB[dir] = (bf16x8){0, 0, 0, 0, 0, 0, 0, 0};
            if ((fq >> 1) == dir) wB[dir] = *(const bf16x8*)((const bf16_t*)(p.ws + WS_MISC + MO_WUPT) + (size_t)(dir * 512 + h * 128 + wid * 16 + fr) * 16 + (fq & 1) * 8);
            bias[dir] = *(const f32x4*)(p.in[20] + dir * 512 + h * 128 + wid * 16 + fq * 4); } }
    float lb[8];
    if (!GLA) { const float* lbv = (const float*)(p.ws + WS_MISC + MO_LBV) + h * 128 + d8; const f32x4 l0 = *(const f32x4*)lbv, l1 = *(const f32x4*)(lbv + 4);
#pragma unroll
        for (int e = 0; e < 4; ++e) { lb[e] = l0[e]; lb[4 + e] = l1[e]; } }
    store_v<DV>(R.v, vT, tid);
#pragma unroll
    for (int dir = 0; dir < 2; ++dir) {
        const int chain = ((half * 4 + bl) * 4 + h) * 2 + dir;
        bf16_t* st = (GLA ? gla_state(p, chain) : (bf16_t*)(p.ws + WS_ST) + (size_t)chain * 64 * DV * 128) + (size_t)c * DV * 128;
        float* decay = (float*)(p.ws + WS_MISC + MO_DECAY) + ((size_t)chain * 64 + c) * 128;
        float kk[2][8];
        if (GLA) {
            gla_gate(wB[dir], lrA, bias[dir], cum, wid, fr, fq);
#pragma unroll
            for (int i = 0; i < 2; ++i) unpack8(R.k[i], kk[i]);
        } else {
#pragma unroll
            for (int i = 0; i < 2; ++i) { const int j = jb + 32 * i; float lf[8]; hg_gate(R.k[GLA ? 0 : dir * 2 + i], lb, lf, kk[i]);
                *(PG8_LAS f32x4*)(cum + j * 128 + d8) = (f32x4){lf[0], lf[1], lf[2], lf[3]}; *(PG8_LAS f32x4*)(cum + j * 128 + d8 + 4) = (f32x4){lf[4], lf[5], lf[6], lf[7]}; }
        }
        __syncthreads();
        chunk_scan(cum, segt, dir, tid);
        __syncthreads();
        { const int lrow = dir ? 0 : 63;
          float last[8]; { const f32x4 l0 = *(PG8_LAS f32x4*)(cum + lrow * 128 + d8), l1 = *(PG8_LAS f32x4*)(cum + lrow * 128 + d8 + 4);
#pragma unroll
              for (int e = 0; e < 4; ++e) { last[e] = l0[e]; last[4 + e] = l1[e]; } }
#pragma unroll
          for (int i = 0; i < 2; ++i) { const int j = jb + 32 * i; const f32x4 c0 = *(PG8_LAS f32x4*)(cum + j * 128 + d8), c1 = *(PG8_LAS f32x4*)(cum + j * 128 + d8 + 4);
              float ks[8];
#pragma unroll
              for (int e = 0; e < 8; ++e) { const float cv = e < 4 ? c0[e] : c1[e - 4]; ks[e] = kk[i][e] * fexp(last[e] - cv); }
              *(PG8_LAS u32x4*)(ksT + j * 144 + d8) = pack8(ks); }
          if (tid < 128) decay[tid] = fexp(cum[lrow * 128 + tid]); }
        __syncthreads();
        { constexpr int MT = DV / 64; const int m0 = (wid >> 1) * (DV / 4), n0 = (wid & 1) * 64;
          f32x4 acc[MT][4];
#pragma unroll
          for (int mt = 0; mt < MT; ++mt)
#pragma unroll
              for (int nt = 0; nt < 4; ++nt) acc[mt][nt] = (f32x4){0.f, 0.f, 0.f, 0.f};
#pragma unroll
          for (int ks = 0; ks < 2; ++ks) { bf16x8 a[MT], bq[4];
#pragma unroll
              for (int mt = 0; mt < MT; ++mt) a[mt] = frag_tr((PG8_LAS const bf16_t*)vT, DV + 16, ks * 32, m0 + mt * 16, lane);
#pragma unroll
              for (int nt = 0; nt < 4; ++nt) bq[nt] = frag_tr_perm((PG8_LAS const bf16_t*)ksT, 144, ks * 32, n0 + (nt >> 1) * 32, (nt & 1) * 4, lane);
#pragma unroll
              for (int mt = 0; mt < MT; ++mt)
#pragma unroll
                  for (int nt = 0; nt < 4; ++nt) acc[mt][nt] = __builtin_amdgcn_mfma_f32_16x16x32_bf16(bq[nt], a[mt], acc[mt][nt], 0, 0, 0); }
#pragma unroll
          for (int mt = 0; mt < MT; ++mt)
#pragma unroll
              for (int k = 0; k < 2; ++k) { u32x4 pk; pk[0] = cvt_pk_bf16(acc[mt][2 * k][0], acc[mt][2 * k][1]); pk[1] = cvt_pk_bf16(acc[mt][2 * k][2], acc[mt][2 * k][3]);
                  pk[2] = cvt_pk_bf16(acc[mt][2 * k + 1][0], acc[mt][2 * k + 1][1]); pk[3] = cvt_pk_bf16(acc[mt][2 * k + 1][2], acc[mt][2 * k + 1][3]);
                  *(u32x4*)(st + (size_t)(m0 + mt * 16 + fr) * 128 + n0 + k * 32 + fq * 8) = pk; } }
    }
    __syncthreads();
}
template <int DV, bool GLA> __device__ void state_scan(const Params& p, const float* decay, int chain0, int nchains, PG8_LAS unsigned char* lds) {
    constexpr int ELEMS = DV * 128, SL = ELEMS / 4096;
    const int tid = ltid();
    lds_f32p dl = (lds_f32p)lds;
    for (int item = blockIdx.x; item < nchains * SL; item += gridDim.x) {
        const int cl = item / SL, chain = chain0 + cl, sl = item - cl * SL, dir = chain & 1, e0 = sl * 4096 + tid * 8, d8 = e0 & 127;
        bf16_t* sp = (GLA ? gla_state(p, chain) : (bf16_t*)(p.ws + WS_ST) + (size_t)chain * 64 * ELEMS) + e0; const float* dp = decay + (size_t)chain * 64 * 128;
#pragma unroll
        for (int i = 0; i < 4; ++i) *(PG8_LAS f32x4*)(dl + (tid + 512 * i) * 4) = *(const f32x4*)(dp + (tid + 512 * i) * 4);
        __syncthreads();
        float S[8];
#pragma unroll
        for (int e = 0; e < 8; ++e) S[e] = 0.f;
        for (int cb = 0; cb < 64; cb += 8) { u32x4 raw[8];
#pragma unroll
            for (int q = 0; q < 8; ++q) { const int c = dir ? 63 - (cb + q) : cb + q; raw[q] = *(const u32x4*)(sp + (size_t)c * ELEMS); }
#pragma unroll
            for (int q = 0; q < 8; ++q) { const int c = dir ? 63 - (cb + q) : cb + q; float u[8]; unpack8(raw[q], u);
                const f32x4 dc0 = *(PG8_LAS f32x4*)(dl + c * 128 + d8), dc1 = *(PG8_LAS f32x4*)(dl + c * 128 + d8 + 4);
                *(u32x4*)(sp + (size_t)c * ELEMS) = pack8(S);
#pragma unroll
                for (int e = 0; e < 8; ++e) S[e] = (e < 4 ? dc0[e] : dc1[e - 4]) * S[e] + u[e]; } }
        __syncthreads();
    }
}
template <bool GLA> struct RawC { u32x4 v[GLA ? 4 : 2]; u32x4 k[GLA ? 1 : 4]; };
template <bool GLA> __device__ __forceinline__ void mix_c_load(const Params& p, int it, int half, RawC<GLA>& R) {
    constexpr int DV = GLA ? 256 : 128, G8 = DV / 8;
    const int c = it & 63, h = (it >> 6) & 3, bl = it >> 8, b = half * 4 + bl;
    const int tid = ltid(), lane = tid & 63, wid = tid >> 6, fr = lane & 15, fq = lane >> 4;
    const size_t tok0 = (size_t)b * SEQ + c * 64;
    const bf16_t* proj = (const bf16_t*)(p.ws + WS_A);
    const int d8 = (tid & 15) * 8, jb = tid >> 4;
#pragma unroll
    for (int i = 0; i < DV / 64; ++i) { const int idx = tid + 512 * i, j = idx / G8, c8 = (idx % G8) * 8;
        R.v[i] = *(const u32x4*)(GLA ? proj + (tok0 + j) * N_GLA + 1024 + h * 256 + c8 : proj + (tok0 + j) * N_AB + 2560 + h * 128 + c8); }
#pragma unroll
    for (int i = 0; i < 2; ++i) { const int j = jb + 32 * i;
        if (!GLA) { const bf16_t* rp = proj + (tok0 + j) * N_AB + h * 128 + d8; R.k[i] = *(const u32x4*)(rp + 1536); R.k[GLA ? 0 : 2 + i] = *(const u32x4*)(rp + 2048); } }
}
template <bool GLA> __device__ __forceinline__ void mix_c_compute(const Params& p, PG8_LAS unsigned char* lds, int it, int half, const RawC<GLA>& R) {
    constexpr int DV = GLA ? 256 : 128, NT = DV / 128;
    const int c = it & 63, h = (it >> 6) & 3, bl = it >> 8, b = half * 4 + bl;
    const int tid = ltid(), lane = tid & 63, wid = tid >> 6, fr = lane & 15, fq = lane >> 4;
    lds_f32p cum = (lds_f32p)lds; lds_bf16p qin = (lds_bf16p)(lds + 32768); lds_bf16p kin = (lds_bf16p)(lds + 50176); lds_bf16p qc = (lds_bf16p)(lds + 67584);
    lds_bf16p P = (lds_bf16p)(lds + 84992); lds_bf16p vT = (lds_bf16p)(lds + 94208); lds_f32p segt = (lds_f32p)(lds + LDS_SEGT); lds_f32p red = (lds_f32p)(lds + LDS_RED);
    const size_t tok0 = (size_t)b * SEQ + c * 64;
    const bf16_t* proj = (const bf16_t*)(p.ws + WS_A);
    const int d8 = (tid & 15) * 8, jb = tid >> 4, n0 = wid * NT * 16;
    u32x4 qraw[2], kg[2];
#pragma unroll
    for (int i = 0; i < 2; ++i) { const int j = jb + 32 * i;
        if (GLA) { const bf16_t* rp = proj + (tok0 + j) * N_GLA + h * 128 + d8; qraw[i] = *(const u32x4*)rp; kg[i] = *(const u32x4*)(rp + 512); }
        else { qraw[i] = *(const u32x4*)(proj + (tok0 + j) * N_AB + 1024 + h * 128 + d8); kg[i] = qraw[i]; } }
    bf16x8 lrA[4], wB[2]; f32x4 gbias[2];
    if (GLA) {
#pragma unroll
        for (int mt = 0; mt < 4; ++mt) lrA[mt] = *(const bf16x8*)(proj + (tok0 + mt * 16 + fr) * N_GLA + 3072 + fq * 8);
#pragma unroll
        for (int dir = 0; dir < 2; ++dir) { wB[dir] = (bf16x8){0, 0, 0, 0, 0, 0, 0, 0};
            if ((fq >> 1) == dir) wB[dir] = *(const bf16x8*)((const bf16_t*)(p.ws + WS_MISC + MO_WUPT) + (size_t)(dir * 512 + h * 128 + wid * 16 + fr) * 16 + (fq & 1) * 8);
            gbias[dir] = *(const f32x4*)(p.in[20] + dir * 512 + h * 128 + wid * 16 + fq * 4); }
    }
    float lb[8];
    if (!GLA) { const float* lbv = (const float*)(p.ws + WS_MISC + MO_LBV) + h * 128 + d8; const f32x4 l0 = *(const f32x4*)lbv, l1 = *(const f32x4*)(lbv + 4);
#pragma unroll
        for (int e = 0; e < 4; ++e) { lb[e] = l0[e]; lb[4 + e] = l1[e]; } }
    store_v<DV>(R.v, vT, tid);
    f32x4 o[4][NT];
#pragma unroll
    for (int mt = 0; mt < 4; ++mt)
#pragma unroll
        for (int nt = 0; nt < NT; ++nt) o[mt][nt] = (f32x4){0.f, 0.f, 0.f, 0.f};
#pragma unroll
    for (int dir = 0; dir < 2; ++dir) {
        bf16x8 sB[NT][4];
        { const int chain = ((half * 4 + bl) * 4 + h) * 2 + dir;
          const bf16_t* st = (GLA ? gla_state(p, chain) : (bf16_t*)(p.ws + WS_ST) + (size_t)chain * 64 * DV * 128) + (size_t)c * DV * 128;
#pragma unroll
          for (int nt = 0; nt < NT; ++nt)
#pragma unroll
              for (int ks = 0; ks < 4; ++ks) sB[nt][ks] = *(const bf16x8*)(st + (size_t)(NT == 2 ? n0 + (fr >> 2) * 8 + nt * 4 + (fr & 3) : n0 + nt * 16 + fr) * 128 + ks * 32 + fq * 8); }
        float kk[2][8];
        if (GLA) { gla_gate(wB[dir], lrA, gbias[dir], cum, wid, fr, fq);
#pragma unroll
            for (int i = 0; i < 2; ++i) unpack8(kg[i], kk[i]);
        } else {
#pragma unroll
            for (int i = 0; i < 2; ++i) { const int j = jb + 32 * i; float lf[8]; hg_gate(R.k[GLA ? 0 : dir * 2 + i], lb, lf, kk[i]);
                *(PG8_LAS f32x4*)(cum + j * 128 + d8) = (f32x4){lf[0], lf[1], lf[2], lf[3]}; *(PG8_LAS f32x4*)(cum + j * 128 + d8 + 4) = (f32x4){lf[4], lf[5], lf[6], lf[7]}; }
        }
        __syncthreads();
        chunk_scan(cum, segt, dir, tid);
        __syncthreads();
        { const int jref = dir ? 31 : 32;
          float ref[8]; { const f32x4 l0 = *(PG8_LAS f32x4*)(cum + jref * 128 + d8), l1 = *(PG8_LAS f32x4*)(cum + jref * 128 + d8 + 4);
#pragma unroll
              for (int e = 0; e < 4; ++e) { ref[e] = l0[e]; ref[4 + e] = l1[e]; } }
#pragma unroll
          for (int i = 0; i < 2; ++i) { const int j = jb + 32 * i; const f32x4 c0 = *(PG8_LAS f32x4*)(cum + j * 128 + d8), c1 = *(PG8_LAS f32x4*)(cum + j * 128 + d8 + 4);
              float q[8], a[8], bb[8], cc[8]; unpack8(qraw[i], q);
#pragma unroll
              for (int e = 0; e < 8; ++e) { const float cv = e < 4 ? c0[e] : c1[e - 4];
                  const float qq = GLA ? q[e] * 0.08838834764831845f : q[e] * frcp(1.0f + fexp(-q[e]));
                  a[e] = qq * fexp(cv - ref[e]); bb[e] = kk[i][e] * fexp(ref[e] - cv); cc[e] = qq * fexp(cv); }
              *(PG8_LAS u32x4*)(qin + j * 136 + d8) = pack8(a); *(PG8_LAS u32x4*)(kin + j * 136 + d8) = pack8(bb); *(PG8_LAS u32x4*)(qc + j * 136 + d8) = pack8(cc); } }
        __syncthreads();
        { f32x4 s[1][2]; s[0][0] = (f32x4){0.f, 0.f, 0.f, 0.f}; s[0][1] = s[0][0];
          const int m0 = (wid & 3) * 16, l = m0 + fr, sn0 = (wid >> 2) * 32;
          mma_tiles<1, 2, false, false, 128>(s, (PG8_LAS const bf16_t*)qin, 136, m0, (PG8_LAS const bf16_t*)kin, 136, sn0, fr, fq);
#pragma unroll
          for (int nt = 0; nt < 2; ++nt) { const int mc = sn0 + nt * 16 + fq * 4; float v[4];
#pragma unroll
              for (int e = 0; e < 4; ++e) { const bool keep = dir ? (l <= mc + e) : (l >= mc + e); v[e] = keep ? s[0][nt][e] : 0.f; }
              u32x2 pk; pk[0] = cvt_pk_bf16(v[0], v[1]); pk[1] = cvt_pk_bf16(v[2], v[3]); *(PG8_LAS u32x2*)(P + l * 72 + mc) = pk; } }
        __syncthreads();
#pragma unroll
        for (int ks = 0; ks < 2; ++ks) { bf16x8 a[4], bq[NT];
#pragma unroll
            for (int mt = 0; mt < 4; ++mt) a[mt] = *(PG8_LAS const bf16x8*)(P + (mt * 16 + fr) * 72 + ks * 32 + fq * 8);
#pragma unroll
            for (int nt = 0; nt < NT; ++nt) bq[nt] = NT == 2 ? frag_tr_perm((PG8_LAS const bf16_t*)vT, DV + 16, ks * 32, n0, nt * 4, lane) : frag_tr((PG8_LAS const bf16_t*)vT, DV + 16, ks * 32, n0 + nt * 16, lane);
#pragma unroll
            for (int mt = 0; mt < 4; ++mt)
#pragma unroll
                for (int nt = 0; nt < NT; ++nt) o[mt][nt] = __builtin_amdgcn_mfma_f32_16x16x32_bf16(bq[nt], a[mt], o[mt][nt], 0, 0, 0); }
#pragma unroll
        for (int ks = 0; ks < 4; ++ks) { bf16x8 a[4];
#pragma unroll
            for (int mt = 0; mt < 4; ++mt) a[mt] = *(PG8_LAS const bf16x8*)(qc + (mt * 16 + fr) * 136 + ks * 32 + fq * 8);
#pragma unroll
            for (int mt = 0; mt < 4; ++mt)
#pragma unroll
                for (int nt = 0; nt < NT; ++nt) o[mt][nt] = __builtin_amdgcn_mfma_f32_16x16x32_bf16(sB[nt][ks], a[mt], o[mt][nt], 0, 0, 0);
            if (ks & 1) __builtin_amdgcn_sched_barrier(0); }
        __builtin_amdgcn_sched_barrier(0);
    }
    const float* gain = (GLA ? p.in[21] : p.in[16]) + h * DV;
    u32x2 graw[4][NT];
#pragma unroll
    for (int mt = 0; mt < 4; ++mt)
#pragma unroll
        for (int nt = 0; nt < NT; ++nt) { const size_t tok = tok0 + mt * 16 + fr; const int col = NT == 2 ? n0 + fq * 8 + nt * 4 : n0 + nt * 16 + fq * 4;
            graw[mt][nt] = *(const u32x2*)(GLA ? proj + tok * N_GLA + 2048 + h * 256 + col : proj + tok * N_AB + 3072 + h * 128 + col); }
#pragma unroll
    for (int mt = 0; mt < 4; ++mt) { float ss = 0.f;
#pragma unroll
        for (int nt = 0; nt < NT; ++nt)
#pragma unroll
            for (int e = 0; e < 4; ++e) ss += o[mt][nt][e] * o[mt][nt][e];
        ss += __shfl_xor(ss, 16); ss += __shfl_xor(ss, 32);
        if (fq == 0) red[wid * 64 + mt * 16 + fr] = ss; }
    __syncthreads();
#pragma unroll
    for (int mt = 0; mt < 4; ++mt) { const int row = mt * 16 + fr; float tot = 0.f;
#pragma unroll
        for (int w = 0; w < 8; ++w) tot += red[w * 64 + row];
        const float rstd = rsqrtf(tot * (1.0f / DV) + EPS);
        bf16_t* outp = (bf16_t*)p.out + (tok0 + row) * 1024 + (GLA ? 0 : 512) + h * DV;
        unsigned pkw[2 * NT];
#pragma unroll
        for (int nt = 0; nt < NT; ++nt) { const int col = NT == 2 ? n0 + fq * 8 + nt * 4 : n0 + nt * 16 + fq * 4; const f32x4 gn = *(const f32x4*)(gain + col); float y[4];
#pragma unroll
            for (int e = 0; e < 4; ++e) { const unsigned wv = graw[mt][nt][e >> 1]; const float gv = __uint_as_float((e & 1) ? (wv & 0xffff0000u) : (wv << 16));
                y[e] = o[mt][nt][e] * rstd * gn[e] * (gv * frcp(1.0f + fexp(-gv))); }
            pkw[2 * nt] = cvt_pk_bf16(y[0], y[1]); pkw[2 * nt + 1] = cvt_pk_bf16(y[2], y[3]); }
        if (NT == 2) { u32x4 pk; pk[0] = pkw[0]; pk[1] = pkw[1]; pk[2] = pkw[2 * NT - 2]; pk[3] = pkw[2 * NT - 1]; *(u32x4*)(outp + n0 + fq * 8) = pk; }
        else { u32x2 pk; pk[0] = pkw[0]; pk[1] = pkw[1]; *(u32x2*)(outp + n0 + fq * 4) = pk; } }
    __syncthreads();
}

template <bool GLA> __device__ __forceinline__ void mix_a_phase(const Params& p, PG8_LAS unsigned char* lds, int nitems, int half) {
    RawA<GLA> A{}, B{}; int it = blockIdx.x; const int G = gridDim.x; if (it < nitems) mix_a_load<GLA>(p, it, half, A);
    while (it < nitems) {
        if (it + G < nitems) mix_a_load<GLA>(p, it + G, half, B);
        mix_a_compute<GLA>(p, lds, it, half, A); it += G; if (it >= nitems) break;
        if (it + G < nitems) mix_a_load<GLA>(p, it + G, half, A);
        mix_a_compute<GLA>(p, lds, it, half, B); it += G; }
}
template <bool GLA> __device__ __forceinline__ void mix_c_phase(const Params& p, PG8_LAS unsigned char* lds, int nitems, int half) {
    RawC<GLA> A{}, B{}; int it = blockIdx.x; const int G = gridDim.x; if (it < nitems) mix_c_load<GLA>(p, it, half, A);
    while (it < nitems) {
        if (it + G < nitems) mix_c_load<GLA>(p, it + G, half, B);
        mix_c_compute<GLA>(p, lds, it, half, A); it += G; if (it >= nitems) break;
        if (it + G < nitems) mix_c_load<GLA>(p, it + G, half, A);
        mix_c_compute<GLA>(p, lds, it, half, B); it += G; }
}
template <bool FINAL> __device__ __forceinline__ void rg_phase(const Params& p, PG8_LAS unsigned char* lds) {
    RawR<FINAL> A{}, B{}; RgW W{}; int it = blockIdx.x; const int G = gridDim.x; const bool gconst = (G & 7) == 0;
    if (it < 4096) { rg_load_w(p, it & 7, W); rg_load<FINAL>(p, it, A); }
    while (it < 4096) {
        if (it + G < 4096) rg_load<FINAL>(p, it + G, B);
        if (!gconst) rg_load_w(p, it & 7, W);
        rg_compute<FINAL>(p, lds, it, A, W); it += G; if (it >= 4096) break;
        if (it + G < 4096) rg_load<FINAL>(p, it + G, A);
        if (!gconst) rg_load_w(p, it & 7, W);
        rg_compute<FINAL>(p, lds, it, B, W); it += G; }
}
#define XB_TMO      128
#define XB_XCNT(j)  (256  + 64 * (j))
#define XB_XSUB(j)  (1280 + 64 * (j))
#define XB_XGEN(j)  (2304 + 64 * (j))
#define XB_TOP      3328
#define XB_TOPGEN   3392
#define XCD_BAR_WORDS 3456
#define XB_SPIN_CAP (1u << 18)
#define LAS __attribute__((address_space(3)))

__device__ __forceinline__ unsigned xb_ld(unsigned* p)              { return __hip_atomic_load(p, __ATOMIC_RELAXED, __HIP_MEMORY_SCOPE_AGENT); }
__device__ __forceinline__ unsigned xb_add(unsigned* p, unsigned v) { return __hip_atomic_fetch_add(p, v, __ATOMIC_RELAXED, __HIP_MEMORY_SCOPE_AGENT); }
__device__ __forceinline__ unsigned xb_xcc_id() { return (unsigned)__builtin_amdgcn_s_getreg((3 << 11) | 20) & 0xFu; }
#define XB_SPIN(cond, bar) do { unsigned _sp = 0; while (cond) { __builtin_amdgcn_s_sleep(1); \
    if ((++_sp & 255u) == 0u) { if (xb_ld(&(bar)[XB_TMO])) break; if (_sp > XB_SPIN_CAP) { atomicAdd(&(bar)[XB_TMO], 1u); break; } } } } while (0)

struct XcdBarrier {
    unsigned* bar; unsigned x;
    volatile LAS unsigned* st;
};

__device__ __forceinline__ XcdBarrier xcd_barrier_post(unsigned* bar, volatile LAS unsigned* st) {
    XcdBarrier b; b.bar = bar; b.x = xb_xcc_id(); b.st = st;
    if (threadIdx.x == 0) (void)xb_add(&bar[XB_XCNT(b.x)], 1u);
    return b;
}
__device__ __forceinline__ void xcd_barrier_complete(unsigned* bar, unsigned x, unsigned& nloc, unsigned& nx) {
    const unsigned G = gridDim.x * gridDim.y * gridDim.z;
    unsigned sum, cnt, mine, sp = 0u;
    for (;;) {
        sum = 0u; cnt = 0u; mine = 0u;
#pragma unroll
        for (unsigned j = 0; j < 16; ++j) { const unsigned c = xb_ld(&bar[XB_XCNT(j)]); sum += c; cnt += (c > 0u) ? 1u : 0u; mine = (j == x) ? c : mine; }
        if (sum == G) break;
        __builtin_amdgcn_s_sleep(1);
        if ((++sp & 255u) == 0u) { if (xb_ld(&bar[XB_TMO])) break; if (sp > XB_SPIN_CAP) { atomicAdd(&bar[XB_TMO], 1u); break; } }
    }
    nloc = mine > 0u ? mine : 1u; nx = cnt > 0u ? cnt : 1u;
}

__device__ __forceinline__ void xcd_barrier(const XcdBarrier& b) {
    asm volatile("s_waitcnt vmcnt(0)" ::: "memory");
    __syncthreads();
    if (threadIdx.x == 0) {
        unsigned* bar = b.bar;
        __builtin_amdgcn_s_waitcnt(0);
        unsigned nloc = b.st[0], nx = b.st[1];
        if (nloc == 0u) { xcd_barrier_complete(bar, b.x, nloc, nx); b.st[0] = nloc; b.st[1] = nx; }
        const unsigned old = xb_add(&bar[XB_XSUB(b.x)], 1u);
        const unsigned gen = old / nloc;
        if (old + 1u == (gen + 1u) * nloc) {
            __builtin_amdgcn_fence(__ATOMIC_RELEASE, "agent");
            asm volatile("s_waitcnt vmcnt(0)" ::: "memory");
            const unsigned og = xb_add(&bar[XB_TOP], 1u);
            const unsigned tg = og / nx;
            if (og + 1u == (tg + 1u) * nx) xb_add(&bar[XB_TOPGEN], 1u);
            else XB_SPIN(xb_ld(&bar[XB_TOPGEN]) == tg, bar);
            __builtin_amdgcn_fence(__ATOMIC_ACQUIRE, "agent");
            xb_add(&bar[XB_XGEN(b.x)], 1u);
            asm volatile("s_waitcnt vmcnt(0)" ::: "memory");
        } else {
            XB_SPIN(xb_ld(&bar[XB_XGEN(b.x)]) == gen, bar);
            __builtin_amdgcn_fence(__ATOMIC_ACQUIRE, "agent");
            asm volatile("s_waitcnt vmcnt(0)" ::: "memory");
        }
    }
    __syncthreads();
}

constexpr int NPHASE = 19;
constexpr int LDS_BAR = 135168, LDS_BYTES = 135184;
__device__ __forceinline__ void run_phase(const Params& p, PG8_LAS unsigned char* lds, int ph) {
    bf16_t* W = (bf16_t*)(p.ws + WS_W);
    u64* sumsq = (u64*)(p.ws + WS_SS);
    bf16_t* R1 = (bf16_t*)(p.ws + WS_R1); bf16_t* RA = (bf16_t*)(p.ws + WS_A); bf16_t* OB = (bf16_t*)p.out;
    switch (ph) {
    case 0: phase_prep(p, lds); break;
    case 1: case 8: { EpiScale<0> E; E.O = RA; E.ldc = ph == 1 ? N_AB : N_GLA; E.sumsq = sumsq + (ph == 1 ? 0 : 2 * MTOK);
        run_gemm(lds, R1, W + (ph == 1 ? WO_ABIN : WO_GLAIN), ph == 1 ? N_AB : N_GLA, 1024, E); } break;
    case 2: for (int pass = 0; pass < 2; ++pass) { if (((pass ^ (int)blockIdx.x) & 1) == 0) mix_a_phase<false>(p, lds, 2048, 0); else rg_phase<false>(p, lds); } break;
    case 3: state_scan<128, false>(p, (const float*)(p.ws + WS_MISC + MO_DECAY), 0, 64, lds); rg_carry(p); break;
    case 4: for (int pass = 0; pass < 2; ++pass) { if (((pass ^ (int)blockIdx.x) & 1) == 0) mix_c_phase<false>(p, lds, 2048, 0); else rg_phase<true>(p, lds); } break;
    case 5: { EpiResid<true> E; E.Xin = p.in[0]; E.H = R1; E.sumsq = sumsq + 1 * MTOK; run_gemm(lds, OB, W + WO_ABOUT, 1024, 1024, E); } break;
    case 7: case 15: case 17: { EpiResid<false> E; E.Xin = nullptr; E.H = R1; E.sumsq = sumsq + (ph == 7 ? 2 : ph == 15 ? 3 : 4) * MTOK;
        run_gemm(lds, ph == 15 ? OB : RA, W + (ph == 7 ? WO_W2_0 : ph == 15 ? WO_GLAOUT : WO_W2_1), 1024, ph == 15 ? 1024 : 4096, E); } break;
    case 6: case 16: { EpiScale<1> E; E.O = RA; E.ldc = DFF; E.sumsq = sumsq + (ph == 6 ? 1 : 3) * MTOK;
        run_gemm(lds, R1, W + (ph == 6 ? WO_W1_0 : WO_W1_1), DFF, 1024, E); } break;
    case 9: mix_a_phase<true>(p, lds, 1024, 0); break;
    case 10: for (int pass = 0; pass < 2; ++pass) { if (((pass ^ (int)blockIdx.x) & 1) == 0) state_scan<256, true>(p, (const float*)(p.ws + WS_MISC + MO_DECAY), 0, 32, lds); else mix_a_phase<true>(p, lds, 1024, 1); } break;
    case 11: for (int pass = 0; pass < 2; ++pass) { if (((pass ^ (int)blockIdx.x) & 1) == 0) mix_c_phase<true>(p, lds, 1024, 0); else state_scan<256, true>(p, (const float*)(p.ws + WS_MISC + MO_DECAY), 32, 32, lds); } break;
    case 12: mix_c_phase<true>(p, lds, 1024, 1); break;
    case 18: phase_final(p); break;
    }
}
#if MULTI
template <int PH> __global__ void __launch_bounds__(512, 2) k_phase(Params p) {
    extern __shared__ __attribute__((aligned(16))) unsigned char shm[];
    run_phase(p, (PG8_LAS unsigned char*)shm, PH);
}
#else
__global__ void __launch_bounds__(512, 2) k_mega(Params p) {
    extern __shared__ __attribute__((aligned(16))) unsigned char shm[];
    cg::grid_group grid = cg::this_grid();
#ifdef ONLY_PH
    run_phase(p, (PG8_LAS unsigned char*)shm, ONLY_PH);
#else
#define PH_(n) { const Params q = load_params(); run_phase(q, (PG8_LAS unsigned char*)shm, n); \
        XcdBarrier xb; xb.bar = (unsigned*)(q.ws + WS_MISC + MO_BAR); xb.x = xb_xcc_id(); xb.st = st; xcd_barrier(xb); }
    volatile LAS unsigned* st = (volatile LAS unsigned*)((PG8_LAS unsigned char*)shm + LDS_BAR);
    if (threadIdx.x == 0) { st[0] = 0u; st[1] = 0u; }
    __syncthreads();
    { const Params q = load_params();
      if (q.ws == nullptr) grid.sync();
      (void)xcd_barrier_post((unsigned*)(q.ws + WS_MISC + MO_BAR), st); }
    PH_(0) PH_(1) PH_(2) PH_(3) PH_(4) PH_(5) PH_(6) PH_(7) PH_(8) PH_(9) PH_(10) PH_(11) PH_(12) PH_(15) PH_(16) PH_(17)
    { const Params q = load_params(); run_phase(q, (PG8_LAS unsigned char*)shm, 18); }
#endif
}
#endif

extern "C" void kernel_launch(void* const* d_in, const int* in_sizes, int n_in, void* d_out, int out_size, void* d_ws, size_t ws_size, hipStream_t stream) {
    static int grid = 0;
    if (grid == 0) {
        if (n_in != 22 || ws_size < WS_END) { fprintf(stderr, "kernel_launch: unexpected n_in %d / ws_size %zu (need %zu)\n", n_in, ws_size, (size_t)WS_END); }
        int dev = 0, cus = 0, per_cu = 0;
        hipGetDevice(&dev); hipDeviceGetAttribute(&cus, hipDeviceAttributeMultiprocessorCount, dev);
#if MULTI
#define SA_(n) hipFuncSetAttribute((const void*)k_phase<n>, hipFuncAttributeMaxDynamicSharedMemorySize, LDS_BYTES);
        SA_(0) SA_(1) SA_(2) SA_(3) SA_(4) SA_(5) SA_(6) SA_(7) SA_(8) SA_(9) SA_(10) SA_(11) SA_(12) SA_(13) SA_(14) SA_(15) SA_(16) SA_(17) SA_(18)
        per_cu = 1;
#else
        hipFuncSetAttribute((const void*)k_mega, hipFuncAttributeMaxDynamicSharedMemorySize, LDS_BYTES);
        hipOccupancyMaxActiveBlocksPerMultiprocessor(&per_cu, (const void*)k_mega, 512, LDS_BYTES);
#endif
        if (per_cu < 1) { fprintf(stderr, "kernel_launch: occupancy query says %d blocks per CU\n", per_cu); per_cu = 1; }
        if (per_cu > 1) per_cu = 1;
        grid = cus * per_cu;
    }
    Params p{};
    for (int i = 0; i < 22; ++i) p.in[i] = (const float*)d_in[i];
    p.out = (float*)d_out; p.ws = (unsigned char*)d_ws;
#if MULTI
#define LP_(n) k_phase<n><<<dim3(grid), dim3(512), LDS_BYTES, stream>>>(p);
    LP_(0) LP_(1) LP_(2) LP_(3) LP_(4) LP_(5) LP_(6) LP_(7) LP_(8) LP_(9) LP_(10) LP_(11) LP_(12) LP_(13) LP_(14) LP_(15) LP_(16) LP_(17) LP_(18)
#else
    (void)hipMemsetAsync((unsigned char*)d_ws + WS_MISC + MO_BAR, 0, XCD_BAR_WORDS * sizeof(unsigned), stream);
    void* args[] = {&p};
    hipError_t e = hipLaunchCooperativeKernel((const void*)k_mega, dim3(grid), dim3(512), args, LDS_BYTES, stream);
    if (e != hipSuccess) fprintf(stderr, "cooperative launch failed: %s (grid %d)\n", hipGetErrorString(e), grid);
#endif
}
```

```cpp
#include <hip/hip_runtime.h>
#include <hip/hip_cooperative_groups.h>
#include <cstdio>
namespace cg = cooperative_groups;

#ifndef MULTI
#define MULTI 0
#endif

#define PG8_LAS __attribute__((address_space(3)))
typedef unsigned short bf16_t;
typedef short bf16x8 __attribute__((ext_vector_type(8)));
typedef float f32x4 __attribute__((ext_vector_type(4)));
typedef unsigned u32x4 __attribute__((ext_vector_type(4)));
typedef unsigned u32x2 __attribute__((ext_vector_type(2)));

__device__ __forceinline__ int ltid() { int t = threadIdx.x; asm volatile("" : "+v"(t)); return t; }
namespace pg8 {
constexpr int BM = 256, BK = 64, HALF = 128, HTB = HALF * BK * 2, STAGE_BYTES = 8 * HTB, NXCD = 8, WGM = 4;
__host__ __device__ __forceinline__ int lds_byte(int r, int c) { const int st = (r >> 4) * 2 + (c >> 5), rr = r & 15, cc = c & 31, ob = rr * 64 + cc * 2; return st * 1024 + (ob ^ (((ob >> 9) & 1) << 5)); }
__host__ __device__ __forceinline__ void stage_rc(int b, int& R, int& C) { const int st = b / 1024, sb = b % 1024, swz = sb ^ (((sb >> 9) & 1) << 5); R = (st >> 1) * 16 + swz / 64; C = (st & 1) * 32 + (swz % 64) / 2; }
__host__ __device__ __forceinline__ int perm32(int rho) { const int n = rho >> 4, i = rho & 15; return 8 * (i >> 2) + 4 * n + (i & 3); }
struct Unit { int pm, pn; };
struct Gemm { const bf16_t* A; const bf16_t* Bt; int M, N, K; };
struct StaticOrder {
    int nM, nN, nwg, G, c;
    __host__ __device__ void init(int M, int N, int G_, int c_) { nM = M / BM; nN = N / BM; nwg = nM * nN; G = G_; c = c_; }
    __host__ __device__ bool next(int i, Unit& u) const {
        const long L = (long)i * G + c; if (L >= nwg) return false;
        int wgid = (int)L; { const int q = nwg / NXCD, r = nwg % NXCD, xcd = wgid % NXCD, off = wgid / NXCD; wgid = (xcd < r ? xcd * (q + 1) : r * (q + 1) + (xcd - r) * q) + off; }
        const int nig = WGM * nN, gid = wgid / nig, fm = gid * WGM, gsz = (nM - fm) < WGM ? (nM - fm) : WGM;
        u.pm = fm + ((wgid % nig) % gsz); u.pn = (wgid % nig) / gsz; return true;
    }
    __device__ __forceinline__ void a_ready(const Unit&) const {}
    __device__ __forceinline__ void done(const Unit&) const {}
};
typedef __bf16 bf16x2_t __attribute__((ext_vector_type(2)));
typedef float f32x2_t __attribute__((ext_vector_type(2)));
__device__ __forceinline__ unsigned cvt_pk_bf16(float lo, float hi) { f32x2_t v = {lo, hi}; bf16x2_t r = __builtin_convertvector(v, bf16x2_t); return __builtin_bit_cast(unsigned, r); }

template <class Epi, class Sched>
__device__ __forceinline__ void gemm_phase(PG8_LAS unsigned char* lds, const Gemm g, const Sched& S, const Epi& E) {
    const int tid = ltid(), wid = __builtin_amdgcn_readfirstlane(tid >> 6), lane = tid & 63, wr = wid >> 2, wc = wid & 3, fr = lane & 15, fq = lane >> 4;
    const int K = g.K, nt = K / BK;
    unsigned voffA[2], voffB[2];
#pragma unroll
    for (int i = 0; i < 2; ++i) { int R, C; stage_rc(tid * 16 + i * 8192, R, C); const int Rb = Epi::PERM ? ((R & ~31) + perm32(R & 31)) : R;
        voffA[i] = (unsigned)(R * K + C) * 2u; voffB[i] = (unsigned)(Rb * K + C) * 2u; }
    const size_t kstep = (size_t)(BK * 2);
    const size_t hstep = (size_t)HALF * K * 2;
    const size_t tstep = 2 * hstep;
    const unsigned ldsw = (unsigned)wid * 1024u;
    const int aoff = lds_byte(wr * 64 + fr, fq * 8), boff = lds_byte(wc * 32 + fr, fq * 8);
#define PG8_SA(b, h) (((b) * 2 + (h)) * HTB)
#define PG8_SB(b, h) ((4 + (b) * 2 + (h)) * HTB)
#define PG8_STAGE(bufoff, gbase, voff) do { _Pragma("unroll") for (int _i = 0; _i < 2; ++_i) \
        __builtin_amdgcn_global_load_lds((const unsigned*)((const char*)(gbase) + (voff)[_i]), (PG8_LAS unsigned*)(lds + (bufoff) + ldsw + _i * 8192), 16, 0, 0); } while (0)
#define PG8_LDA(dst, b, h) do { _Pragma("unroll") for (int m = 0; m < 4; ++m) _Pragma("unroll") for (int k = 0; k < 2; ++k) dst[m][k] = *(const PG8_LAS bf16x8*)(lds + PG8_SA(b, h) + aoff + m * 2048 + k * 1024); } while (0)
#define PG8_LDB(dst, b, h) do { _Pragma("unroll") for (int n = 0; n < 2; ++n) _Pragma("unroll") for (int k = 0; k < 2; ++k) dst[n][k] = *(const PG8_LAS bf16x8*)(lds + PG8_SB(b, h) + boff + n * 2048 + k * 1024); } while (0)
#define PG8_MMA(ai, bj, At, Bt) do { __builtin_amdgcn_s_setprio(1); _Pragma("unroll") for (int m = 0; m < 4; ++m) _Pragma("unroll") for (int n = 0; n < 2; ++n) _Pragma("unroll") for (int k = 0; k < 2; ++k) \
        acc[ai][bj][m][n] = __builtin_amdgcn_mfma_f32_16x16x32_bf16(Bt[n][k], At[m][k], acc[ai][bj][m][n], 0, 0, 0); __builtin_amdgcn_s_setprio(0); } while (0)
#define PG8_WAIT_V(n) asm volatile("s_waitcnt vmcnt(" #n ")" ::: "memory")
#define PG8_WAIT_L(n) asm volatile("s_waitcnt lgkmcnt(" #n ")" ::: "memory")
#define PG8_BAR __builtin_amdgcn_s_barrier()
#define PG8_SCHED __builtin_amdgcn_sched_barrier(0)
    Unit cur, nxt; int ui = 0;
    if (!S.next(0, cur)) return;
    f32x4 acc[2][2][4][2];
#pragma unroll
    for (int a = 0; a < 2; ++a)
#pragma unroll
        for (int b = 0; b < 2; ++b)
#pragma unroll
            for (int m = 0; m < 4; ++m)
#pragma unroll
                for (int n = 0; n < 2; ++n) acc[a][b][m][n] = (f32x4){0.f, 0.f, 0.f, 0.f};
    bf16x8 At[4][2], B0[2][2], B1[2][2];
    const char* cA = (const char*)g.A + (size_t)cur.pm * tstep; const char* cB = (const char*)g.Bt + (size_t)cur.pn * tstep;
    S.a_ready(cur);
    PG8_STAGE(PG8_SB(0, 0), cB, voffB); PG8_STAGE(PG8_SA(0, 0), cA, voffA); PG8_STAGE(PG8_SB(0, 1), cB + hstep, voffB); PG8_STAGE(PG8_SA(0, 1), cA + hstep, voffA);
    if (wr == 1) PG8_BAR;
    PG8_WAIT_V(4); PG8_BAR;
    PG8_STAGE(PG8_SB(1, 0), cB + kstep, voffB); PG8_STAGE(PG8_SA(1, 0), cA + kstep, voffA); PG8_STAGE(PG8_SB(1, 1), cB + hstep + kstep, voffB);
    PG8_WAIT_V(6); PG8_BAR;
    for (;;) {
        const bool has_next = S.next(ui + 1, nxt);
        const char* nA = has_next ? (const char*)g.A + (size_t)nxt.pm * tstep : cA; const char* nB = has_next ? (const char*)g.Bt + (size_t)nxt.pn * tstep : cB;
        for (int t = 0; t < nt; t += 2) {
            const bool last = (t == nt - 2);
            const char* a1 = cA + (size_t)(t + 1) * kstep;
            const char* a2 = last ? nA : cA + (size_t)(t + 2) * kstep; const char* b2 = last ? nB : cB + (size_t)(t + 2) * kstep;
            const char* a3 = a2 + kstep; const char* b3 = b2 + kstep;
            if (last && has_next) S.a_ready(nxt);
            PG8_LDB(B0, 0, 0); PG8_SCHED; PG8_LDA(At, 0, 0); PG8_STAGE(PG8_SA(1, 1), a1 + hstep, voffA);
            PG8_WAIT_L(8); PG8_BAR; PG8_WAIT_L(0); PG8_MMA(0, 0, At, B0); PG8_BAR; PG8_SCHED;
            PG8_LDB(B1, 0, 1); PG8_STAGE(PG8_SB(0, 0), b2, voffB);
            PG8_BAR; PG8_WAIT_L(0); PG8_MMA(0, 1, At, B1); PG8_BAR;
            PG8_LDA(At, 0, 1); PG8_STAGE(PG8_SA(0, 0), a2, voffA);
            PG8_BAR; PG8_WAIT_L(0); PG8_MMA(1, 0, At, B0); PG8_BAR; PG8_SCHED;
            PG8_STAGE(PG8_SB(0, 1), b2 + hstep, voffB);
            PG8_WAIT_V(6); PG8_BAR; PG8_MMA(1, 1, At, B1); PG8_BAR;
            PG8_LDB(B0, 1, 0); PG8_SCHED; PG8_LDA(At, 1, 0); PG8_STAGE(PG8_SA(0, 1), a2 + hstep, voffA);
            PG8_WAIT_L(8); PG8_BAR; PG8_WAIT_L(0); PG8_MMA(0, 0, At, B0); PG8_BAR; PG8_SCHED;
            PG8_LDB(B1, 1, 1); PG8_STAGE(PG8_SB(1, 0), b3, voffB);
            PG8_BAR; PG8_WAIT_L(0); PG8_MMA(0, 1, At, B1); PG8_BAR;
            PG8_LDA(At, 1, 1); PG8_STAGE(PG8_SA(1, 0), a3, voffA);
            PG8_BAR; PG8_WAIT_L(0); PG8_MMA(1, 0, At, B0); PG8_BAR; PG8_SCHED;
            PG8_STAGE(PG8_SB(1, 1), b3 + hstep, voffB);
            PG8_WAIT_V(6); PG8_BAR; PG8_MMA(1, 1, At, B1); PG8_BAR;
        }
        if constexpr (!Epi::AFTER_DRAIN) { E(acc, cur, wr, wc, fr, fq); S.done(cur); }
        if (!has_next) break;
#pragma unroll
        for (int a = 0; a < 2; ++a)
#pragma unroll
            for (int b = 0; b < 2; ++b)
#pragma unroll
                for (int m = 0; m < 4; ++m)
#pragma unroll
                    for (int n = 0; n < 2; ++n) acc[a][b][m][n] = (f32x4){0.f, 0.f, 0.f, 0.f};
        cur = nxt; cA = nA; cB = nB; ++ui;
    }
    PG8_WAIT_V(0);
    if (wr == 0) PG8_BAR;
    PG8_BAR;
    if constexpr (Epi::AFTER_DRAIN) { E.fused(acc, cur, wr, wc, fr, fq, lds, wid, lane); S.done(cur); }
#undef PG8_SA
#undef PG8_SB
#undef PG8_STAGE
#undef PG8_LDA
#undef PG8_LDB
#undef PG8_MMA
#undef PG8_WAIT_V
#undef PG8_WAIT_L
#undef PG8_BAR
#undef PG8_SCHED
}
}
using pg8::cvt_pk_bf16;

constexpr int MTOK = 32768, DM = 1024, SEQ = 4096, NB = 8, NCH = 64;
constexpr int N_AB = 3584, N_GLA = 3328  , N_GLA_SRC = 3104, DFF = 4096;
constexpr float EPS = 1e-6f;
constexpr size_t WO_ABIN = 0, WO_ABOUT = WO_ABIN + (size_t)N_AB * 1024, WO_W1_0 = WO_ABOUT + 1024 * 1024, WO_W2_0 = WO_W1_0 + 4096 * 1024,
                 WO_GLAIN = WO_W2_0 + 4096 * 1024, WO_GLAOUT = WO_GLAIN + (size_t)N_GLA * 1024, WO_W1_1 = WO_GLAOUT + 1024 * 1024, WO_W2_1 = WO_W1_1 + 4096 * 1024,
                 WO_END = WO_W2_1 + 4096 * 1024;
constexpr size_t MiB = 1048576;
constexpr size_t WS_W = 0, WS_MISC = 50 * MiB, WS_R1 = 58 * MiB, WS_A = 122 * MiB, WS_ST = WS_A + 224 * MiB, WS_HB = WS_A + 288 * MiB, WS_STG = WS_A + 208 * MiB, WS_SS = 510 * MiB, WS_END = 512 * MiB;
static_assert(WO_END * 2 <= 50 * MiB, "weights region");
constexpr size_t MO_SUMSQ = 0, MO_LBV = 655360, MO_SPL = 657408, MO_RGW = 1 * MiB, MO_RGA = 2 * MiB, MO_RGH = 4 * MiB, MO_DECAY = 6 * MiB, MO_WUPT = 786432, MO_BAR = 851968;

typedef unsigned long long u64;
constexpr float SS_SCALE = 16777216.0f, SS_INV = 1.0f / (16777216.0f * 1024.0f);
struct Params {
    const float* in[22];
    float* out;
    unsigned char* ws;
};

__device__ __forceinline__ Params load_params() {
#if defined(__HIP_DEVICE_COMPILE__)
    auto q = __builtin_amdgcn_kernarg_segment_ptr();
    asm volatile("" : "+s"(q));
    return *(const __attribute__((address_space(4))) Params*)q;
#else
    return Params{};
#endif
}
__device__ __forceinline__ float bf2f(bf16_t b) { return __uint_as_float(((unsigned)b) << 16); }
__device__ __forceinline__ bf16_t f2bf(float f) { unsigned u = __float_as_uint(f); u += 0x7FFFu + ((u >> 16) & 1u); return (bf16_t)(u >> 16); }
__device__ __forceinline__ float frcp(float x) { return __builtin_amdgcn_rcpf(x); }
__device__ __forceinline__ float fexp(float x) { return __builtin_amdgcn_exp2f(x * 1.4426950408889634f); }
__device__ __forceinline__ float flog(float x) { return __builtin_amdgcn_logf(x) * 0.6931471805599453f; }
__device__ __forceinline__ float sigmoidf_(float x) { return frcp(1.0f + fexp(-x)); }
__device__ __forceinline__ void unpack8(const u32x4 v, float (&f)[8]) {
#pragma unroll
    for (int i = 0; i < 4; ++i) { f[2 * i] = __uint_as_float(v[i] << 16); f[2 * i + 1] = __uint_as_float(v[i] & 0xffff0000u); }
}
__device__ __forceinline__ u32x4 pack8(const float (&f)[8]) { u32x4 r;
#pragma unroll
    for (int i = 0; i < 4; ++i) r[i] = cvt_pk_bf16(f[2 * i], f[2 * i + 1]);
    return r; }

__device__ __forceinline__ bf16_t* gla_state(const Params& p, int chain) {
    unsigned char* base = chain < 45 ? p.ws + WS_STG + (size_t)chain * (4 * MiB)
                        : chain < 61 ? (unsigned char*)p.out + 64 * MiB + (size_t)(chain - 45) * (4 * MiB)
                        : p.ws + WS_W + (size_t)(chain - 61) * (4 * MiB);
    return (bf16_t*)base;
}
template <int ACT> struct EpiScale {
    static constexpr bool PERM = true, AFTER_DRAIN = false;
    bf16_t* O; int ldc; const u64* sumsq;
    __device__ __forceinline__ void operator()(const f32x4 (&acc)[2][2][4][2], const pg8::Unit& u, int wr, int wc, int fr, int fq) const {
        const int row0 = u.pm * 256 + wr * 64 + fr, col0 = u.pn * 256 + wc * 32 + 8 * fq;
        float rs[2][4];
#pragma unroll
        for (int ai = 0; ai < 2; ++ai)
#pragma unroll
            for (int m = 0; m < 4; ++m) rs[ai][m] = (float)sumsq[row0 + ai * 128 + m * 16];
#pragma unroll
        for (int ai = 0; ai < 2; ++ai)
#pragma unroll
            for (int m = 0; m < 4; ++m) rs[ai][m] = rsqrtf(rs[ai][m] * SS_INV + EPS);
#pragma unroll
        for (int ai = 0; ai < 2; ++ai)
#pragma unroll
            for (int m = 0; m < 4; ++m) {
                const int row = row0 + ai * 128 + m * 16;
                bf16_t* rowp = O + (size_t)row * ldc + col0;
#pragma unroll
                for (int bj = 0; bj < 2; ++bj) {
                    f32x4 v0 = acc[ai][bj][m][0] * rs[ai][m], v1 = acc[ai][bj][m][1] * rs[ai][m];
                    if (ACT == 1) {
#pragma unroll
                        for (int e = 0; e < 4; ++e) { float a = fmaxf(v0[e], 0.f), b = fmaxf(v1[e], 0.f); v0[e] = a * a; v1[e] = b * b; }
                    }
                    u32x4 pk; pk[0] = cvt_pk_bf16(v0[0], v0[1]); pk[1] = cvt_pk_bf16(v0[2], v0[3]); pk[2] = cvt_pk_bf16(v1[0], v1[1]); pk[3] = cvt_pk_bf16(v1[2], v1[3]);
                    *(u32x4*)(rowp + bj * 128) = pk;
                }
            }
    }
};
template <bool XIN> struct EpiResid {
    static constexpr bool PERM = true, AFTER_DRAIN = false;
    const float* Xin; bf16_t* H; u64* sumsq;
    __device__ __forceinline__ void operator()(const f32x4 (&acc)[2][2][4][2], const pg8::Unit& u, int wr, int wc, int fr, int fq) const {
        const int row0 = u.pm * 256 + wr * 64 + fr, col0 = u.pn * 256 + wc * 32 + 8 * fq;
#pragma unroll
        for (int ai = 0; ai < 2; ++ai) {
            f32x4 hx[4][2][2]; u32x4 hb[4][2];
#pragma unroll
            for (int m = 0; m < 4; ++m)
#pragma unroll
                for (int bj = 0; bj < 2; ++bj) { const size_t ro = (size_t)(row0 + ai * 128 + m * 16) * 1024 + col0 + bj * 128;
                    if (XIN) { hx[m][bj][0] = *(const f32x4*)(Xin + ro); hx[m][bj][1] = *(const f32x4*)(Xin + ro + 4); } else hb[m][bj] = *(const u32x4*)(H + ro); }
            __builtin_amdgcn_sched_barrier(0);
#pragma unroll
            for (int m = 0; m < 4; ++m) {
                const int row = row0 + ai * 128 + m * 16;
                const size_t ro = (size_t)row * 1024 + col0;
                float ss = 0.f;
#pragma unroll
                for (int bj = 0; bj < 2; ++bj) {
                    f32x4 h0, h1;
                    if (XIN) { h0 = hx[m][bj][0]; h1 = hx[m][bj][1]; } else { float t[8]; unpack8(hb[m][bj], t); h0 = (f32x4){t[0], t[1], t[2], t[3]}; h1 = (f32x4){t[4], t[5], t[6], t[7]}; }
                    const f32x4 v0 = acc[ai][bj][m][0] + h0, v1 = acc[ai][bj][m][1] + h1;
                    u32x4 pk; pk[0] = cvt_pk_bf16(v0[0], v0[1]); pk[1] = cvt_pk_bf16(v0[2], v0[3]); pk[2] = cvt_pk_bf16(v1[0], v1[1]); pk[3] = cvt_pk_bf16(v1[2], v1[3]);
                    *(u32x4*)(H + ro + bj * 128) = pk;
#pragma unroll
                    for (int e = 0; e < 4; ++e) ss += v0[e] * v0[e] + v1[e] * v1[e];
                }
                ss += __shfl_xor(ss, 16); ss += __shfl_xor(ss, 32);
                if (fq == 0) (void)__hip_atomic_fetch_add(sumsq + row, (u64)(ss * SS_SCALE), __ATOMIC_RELAXED, __HIP_MEMORY_SCOPE_AGENT);
            }
            __builtin_amdgcn_sched_barrier(0);
        }
    }
};
template <class Epi> __device__ __forceinline__ void run_gemm(PG8_LAS unsigned char* lds, const bf16_t* A, const bf16_t* Bt, int N, int K, const Epi& E) {
    pg8::Gemm g; g.A = A; g.Bt = Bt; g.M = MTOK; g.N = N; g.K = K;
    pg8::StaticOrder S; S.init(MTOK, N, (int)gridDim.x, (int)blockIdx.x);
    pg8::gemm_phase<Epi, pg8::StaticOrder>(lds, g, S, E);
}

template <int MT, int NT, bool SWA, bool SWB, int K, class PA, class PB>
__device__ __forceinline__ void mma_tiles(f32x4 (&acc)[MT][NT], PA A, int lda, int m0, PB B, int ldb, int n0, int fr, int fq) {
#pragma unroll
    for (int k0 = 0; k0 < K; k0 += 32) {
        bf16x8 a[MT], b[NT];
#pragma unroll
        for (int mt = 0; mt < MT; ++mt) { const int row = m0 + mt * 16 + fr; int kb = (k0 >> 3) + fq; if (SWA) kb ^= (row >> 3) & 7; a[mt] = *(const bf16x8*)(A + row * lda + kb * 8); }
#pragma unroll
        for (int nt = 0; nt < NT; ++nt) { const int row = n0 + nt * 16 + fr; int kb = (k0 >> 3) + fq; if (SWB) kb ^= (row >> 3) & 7; b[nt] = *(const bf16x8*)(B + row * ldb + kb * 8); }
#pragma unroll
        for (int mt = 0; mt < MT; ++mt)
#pragma unroll
            for (int nt = 0; nt < NT; ++nt) acc[mt][nt] = __builtin_amdgcn_mfma_f32_16x16x32_bf16(b[nt], a[mt], acc[mt][nt], 0, 0, 0);
    }
}
typedef PG8_LAS float* lds_f32p;
typedef PG8_LAS bf16_t* lds_bf16p;

__device__ __forceinline__ void transpose_tile(const float* src, bf16_t* dst, const float* scale, int K, int Nsrc, int k0, int n0, lds_f32p T, int tid) {
    { const int r = tid >> 3, c = (tid & 7) * 8;
      f32x4 v0 = {0.f, 0.f, 0.f, 0.f}, v1 = v0;
      if (n0 + c < Nsrc) { const float* sp = src + (size_t)(k0 + r) * Nsrc + n0 + c; v0 = *(const f32x4*)sp; v1 = *(const f32x4*)(sp + 4); }
      const float sc = scale ? scale[k0 + r] : 1.0f;
#pragma unroll
      for (int e = 0; e < 4; ++e) { T[r * 65 + c + e] = v0[e] * sc; T[r * 65 + c + 4 + e] = v1[e] * sc; } }
    __syncthreads();
    { const int n = tid >> 3, kk = (tid & 7) * 8; float f[8];
#pragma unroll
      for (int e = 0; e < 8; ++e) f[e] = T[(kk + e) * 65 + n];
      *(u32x4*)(dst + (size_t)(n0 + n) * K + k0 + kk) = pack8(f); }
    __syncthreads();
}
__device__ __forceinline__ void convert_tiles(const Params& p, PG8_LAS unsigned char* lds, int lo, int hi) {
    const int tid = ltid();
    bf16_t* W = (bf16_t*)(p.ws + WS_W);
    lds_f32p T = (lds_f32p)lds;
    struct TD { const float* src; bf16_t* dst; const float* scale; int K, Nsrc, k0, n0; };
    auto desc = [&](int tile) { TD d; d.scale = nullptr; d.K = 1024; int Npad, base;
        if (tile < 896) { base = 0; d.src = p.in[6]; d.dst = W + WO_ABIN; d.scale = p.in[1]; d.Nsrc = Npad = 3584; }
        else if (tile < 1152) { base = 896; d.src = p.in[7]; d.dst = W + WO_ABOUT; d.Nsrc = Npad = 1024; }
        else if (tile < 2176) { base = 1152; d.src = p.in[4]; d.dst = W + WO_W1_0; d.scale = p.in[2]; d.Nsrc = Npad = 4096; }
        else if (tile < 3200) { base = 2176; d.src = p.in[5]; d.dst = W + WO_W2_0; d.K = 4096; d.Nsrc = Npad = 1024; }
        else if (tile < 4032) { base = 3200; d.src = p.in[17]; d.dst = W + WO_GLAIN; d.scale = p.in[1] + 1024; d.Nsrc = N_GLA_SRC; Npad = N_GLA; }
        else if (tile < 4288) { base = 4032; d.src = p.in[18]; d.dst = W + WO_GLAOUT; d.Nsrc = Npad = 1024; }
        else if (tile < 5312) { base = 4288; d.src = p.in[4] + (size_t)1024 * 4096; d.dst = W + WO_W1_1; d.scale = p.in[2] + 1024; d.Nsrc = Npad = 4096; }
        else { base = 5312; d.src = p.in[5] + (size_t)4096 * 1024; d.dst = W + WO_W2_1; d.K = 4096; d.Nsrc = Npad = 1024; }
        const int local = tile - base, ntn = Npad >> 6, kti = local / ntn, nti = local - kti * ntn; d.k0 = kti * 64; d.n0 = nti * 64; return d; };
    const int r = tid >> 3, c = (tid & 7) * 8;
    auto tload = [&](const TD& d, f32x4& v0, f32x4& v1, float& sc) { v0 = (f32x4){0.f, 0.f, 0.f, 0.f}; v1 = v0;
        if (d.n0 + c < d.Nsrc) { const float* sp = d.src + (size_t)(d.k0 + r) * d.Nsrc + d.n0 + c; v0 = *(const f32x4*)sp; v1 = *(const f32x4*)(sp + 4); }
        sc = d.scale ? d.scale[d.k0 + r] : 1.0f; };
    int tile = lo + blockIdx.x, buf = 0; TD cur = desc(tile < hi ? tile : lo); f32x4 v0, v1; float sc;
    if (tile < hi) tload(cur, v0, v1, sc);
    for (; tile < hi; tile += gridDim.x, buf ^= 1) {
        const int nt_ = tile + gridDim.x; TD nxt = desc(nt_ < hi ? nt_ : lo); f32x4 n0v = v0, n1v = v1; float nsc = sc;
        if (nt_ < hi) tload(nxt, n0v, n1v, nsc);
        lds_f32p Tb = T + buf * (64 * 65);
#pragma unroll
        for (int e = 0; e < 4; ++e) { Tb[r * 65 + c + e] = v0[e] * sc; Tb[r * 65 + c + 4 + e] = v1[e] * sc; }
        __syncthreads();
        { const int n = tid >> 3, kk = (tid & 7) * 8; float f[8];
#pragma unroll
          for (int e = 0; e < 8; ++e) f[e] = Tb[(kk + e) * 65 + n];
          *(u32x4*)(cur.dst + (size_t)(cur.n0 + n) * cur.K + cur.k0 + kk) = pack8(f); }
        cur = nxt; v0 = n0v; v1 = n1v; sc = nsc;
    }
    __syncthreads();
}
__device__ void phase_prep(const Params& p, PG8_LAS unsigned char* lds) {
    const int tid = ltid(), lane = tid & 63, wid = tid >> 6;
    u64* sumsq = (u64*)(p.ws + WS_SS);
    bf16_t* xb = (bf16_t*)(p.ws + WS_R1);
    for (int row = blockIdx.x * 8 + wid; row < MTOK; row += gridDim.x * 8) {
        const float* xr = p.in[0] + (size_t)row * 1024; float ss = 0.f;
#pragma unroll
        for (int i = 0; i < 2; ++i) { const f32x4 v = *(const f32x4*)(xr + i * 512 + lane * 8), w = *(const f32x4*)(xr + i * 512 + lane * 8 + 4);
            ss += v[0] * v[0] + v[1] * v[1] + v[2] * v[2] + v[3] * v[3] + w[0] * w[0] + w[1] * w[1] + w[2] * w[2] + w[3] * w[3];
            u32x4 pk; pk[0] = cvt_pk_bf16(v[0], v[1]); pk[1] = cvt_pk_bf16(v[2], v[3]); pk[2] = cvt_pk_bf16(w[0], w[1]); pk[3] = cvt_pk_bf16(w[2], w[3]);
            *(u32x4*)(xb + (size_t)row * 1024 + i * 512 + lane * 8) = pk; }
#pragma unroll
        for (int o = 32; o >= 1; o >>= 1) ss += __shfl_xor(ss, o);
        if (lane == 0) sumsq[row] = (u64)(ss * SS_SCALE);
    }
    const int gtid = blockIdx.x * 512 + tid, gstride = gridDim.x * 512;
    for (int i = gtid; i < 4 * MTOK; i += gstride) sumsq[MTOK + i] = 0ull;
    { bf16_t* rgw = (bf16_t*)(p.ws + WS_MISC + MO_RGW);
      for (int i = gtid; i < 131072; i += gstride) { const int mat = i >> 15, kind = mat >> 1, dir = mat & 1, g = (i >> 12) & 7, j = (i >> 6) & 63, ii = i & 63;
          const float* s = kind ? p.in[12] : p.in[10]; rgw[i] = f2bf(s[((dir * 8 + g) * 64 + ii) * 64 + j]); } }
    { bf16_t* wupt = (bf16_t*)(p.ws + WS_MISC + MO_WUPT);
      for (int i = gtid; i < 16384; i += gstride) { const int dir = i >> 13, d = (i >> 4) & 511, r = i & 15; wupt[i] = f2bf(p.in[19][(size_t)(dir * 16 + r) * 512 + d]); } }
    { float* lbv = (float*)(p.ws + WS_MISC + MO_LBV); float* spl = (float*)(p.ws + WS_MISC + MO_SPL);
      for (int i = gtid; i < 512; i += gstride) { const float l0 = p.in[15][i], l1 = p.in[15][512 + i]; lbv[i] = 1.0f / (1.0f + expf(l1 - l0)); }
      for (int i = gtid; i < 1024; i += gstride) { const float lam = p.in[14][i]; spl[i] = fmaxf(-lam, 0.f) + log1pf(expf(-fabsf(lam))); } }
    convert_tiles(p, lds, 0, 896);
}
__device__ void phase_final(const Params& p) {
    const int tid = ltid(), lane = tid & 63, wid = tid >> 6;
    const u64* sumsq = (const u64*)(p.ws + WS_SS) + 4 * MTOK;
    const bf16_t* H = (const bf16_t*)(p.ws + WS_R1);
    for (int row = blockIdx.x * 8 + wid; row < MTOK; row += gridDim.x * 8) {
        const float rs = rsqrtf((float)sumsq[row] * SS_INV + EPS);
        float* xr = p.out + (size_t)row * 1024;
#pragma unroll
        for (int i = 0; i < 2; ++i) { const u32x4 raw = *(const u32x4*)(H + (size_t)row * 1024 + i * 512 + lane * 8); float t[8]; unpack8(raw, t);
            const f32x4 g0 = *(const f32x4*)(p.in[3] + i * 512 + lane * 8), g1 = *(const f32x4*)(p.in[3] + i * 512 + lane * 8 + 4);
            f32x4 v0 = (f32x4){t[0], t[1], t[2], t[3]} * rs * g0, v1 = (f32x4){t[4], t[5], t[6], t[7]} * rs * g1;
            *(f32x4*)(xr + i * 512 + lane * 8) = v0; *(f32x4*)(xr + i * 512 + lane * 8 + 4) = v1; }
    }
}

__device__ __forceinline__ float gelu_tanh(float x) { const float y = 0.7978845608028654f * (x + 0.044715f * x * x * x); const float t = 1.0f - 2.0f * frcp(1.0f + fexp(2.0f * y)); return 0.5f * x * (1.0f + t); }
struct RgW { f32x4 cw[4][2], cb[2]; bf16x8 wB[2][2]; f32x4 gb[2], sp[2]; };
template <bool FINAL> struct RawR { u32x4 xr[4]; u32x4 garaw; float carry; };
__device__ __forceinline__ void rg_load_w(const Params& p, int g, RgW& W) {
    const int tid = ltid(), lane = tid & 63, wid = tid >> 6, fr = lane & 15, fq = lane >> 4;
    const int c8 = (tid & 7) * 8, ch = g * 64 + c8;
    const float* spl = (const float*)(p.ws + WS_MISC + MO_SPL);
    const bf16_t* rgw = (const bf16_t*)(p.ws + WS_MISC + MO_RGW);
#pragma unroll
    for (int w = 0; w < 4; ++w) { W.cw[w][0] = *(const f32x4*)(p.in[8] + w * 512 + ch); W.cw[w][1] = *(const f32x4*)(p.in[8] + w * 512 + ch + 4); }
    W.cb[0] = *(const f32x4*)(p.in[9] + ch); W.cb[1] = *(const f32x4*)(p.in[9] + ch + 4);
    const int mat = wid >> 1, nh = wid & 1, kind = mat >> 1, dirm = mat & 1;
#pragma unroll
    for (int nt = 0; nt < 2; ++nt) { const int col = nh * 32 + nt * 16 + fq * 4;
#pragma unroll
        for (int ks = 0; ks < 2; ++ks) W.wB[nt][ks] = *(const bf16x8*)(rgw + (size_t)(mat * 8 + g) * 4096 + (nh * 32 + nt * 16 + fr) * 64 + ks * 32 + fq * 8);
        W.gb[nt] = *(const f32x4*)((kind ? p.in[13] : p.in[11]) + dirm * 512 + g * 64 + col);
        W.sp[nt] = *(const f32x4*)(spl + dirm * 512 + g * 64 + col); }
}
template <bool FINAL> __device__ __forceinline__ void rg_load(const Params& p, int item, RawR<FINAL>& R) {
    const int tid = ltid();
    const int b = item >> 9, c = (item >> 3) & 63, g = item & 7;
    const bf16_t* proj = (const bf16_t*)(p.ws + WS_A);
    const float* RGH = (const float*)(p.ws + WS_MISC + MO_RGH);
    const int j = tid >> 3, c8 = (tid & 7) * 8, ch = g * 64 + c8;
    const size_t tok = (size_t)b * SEQ + c * 64 + j;
#pragma unroll
    for (int w = 0; w < 4; ++w) { const int tt = c * 64 + j + w - 2; R.xr[w] = (u32x4){0u, 0u, 0u, 0u};
        if (tt >= 0 && tt < SEQ) R.xr[w] = *(const u32x4*)(proj + (size_t)(b * SEQ + tt) * N_AB + ch); }
    const int dc = tid & 127, sdir = dc >> 6, sch = dc & 63;
    const size_t so = ((size_t)(b * 2 + sdir) * 64 + c) * 512 + g * 64 + sch;
    R.carry = 0.f; R.garaw = (u32x4){0u, 0u, 0u, 0u};
    if (FINAL) { R.carry = RGH[so]; R.garaw = *(const u32x4*)(proj + tok * N_AB + 512 + ch); }
}
template <bool FINAL> __device__ __forceinline__ void rg_compute(const Params& p, PG8_LAS unsigned char* lds, int item, const RawR<FINAL>& R, const RgW& W) {
    const int tid = ltid(), lane = tid & 63, wid = tid >> 6, fr = lane & 15, fq = lane >> 4;
    const int b = item >> 9, c = (item >> 3) & 63, g = item & 7;
    lds_f32p xc = (lds_f32p)lds; lds_bf16p xcb = (lds_bf16p)(lds + 16384); lds_f32p LA = (lds_f32p)(lds + 25600); lds_f32p LI = (lds_f32p)(lds + 58368);
    lds_f32p SEGP = (lds_f32p)(lds + 91136); lds_f32p SEGH = (lds_f32p)(lds + 93184);
    float* RGA = (float*)(p.ws + WS_MISC + MO_RGA); float* RGH = (float*)(p.ws + WS_MISC + MO_RGH);
    const int j = tid >> 3, c8 = (tid & 7) * 8, ch = g * 64 + c8;
    const size_t tok = (size_t)b * SEQ + c * 64 + j;
    const int mat = wid >> 1, nh = wid & 1, kind = mat >> 1, dirm = mat & 1;
    const int seg = tid >> 7, dc = tid & 127, sdir = dc >> 6, sch = dc & 63;
    const size_t so = ((size_t)(b * 2 + sdir) * 64 + c) * 512 + g * 64 + sch;
    const float carry = R.carry; const u32x4 garaw = R.garaw;
    { float a[8];
#pragma unroll
      for (int e = 0; e < 4; ++e) { a[e] = W.cb[0][e]; a[4 + e] = W.cb[1][e]; }
#pragma unroll
      for (int w = 0; w < 4; ++w) { float x[8]; unpack8(R.xr[w], x);
#pragma unroll
          for (int e = 0; e < 4; ++e) { a[e] += W.cw[w][0][e] * x[e]; a[4 + e] += W.cw[w][1][e] * x[4 + e]; } }
      f32x4 o0, o1;
#pragma unroll
      for (int e = 0; e < 4; ++e) { o0[e] = a[e]; o1[e] = a[4 + e]; }
      *(PG8_LAS f32x4*)(xc + j * 64 + c8) = o0; *(PG8_LAS f32x4*)(xc + j * 64 + c8 + 4) = o1;
      *(PG8_LAS u32x4*)(xcb + j * 72 + c8) = pack8(a); }
    __syncthreads();
    { f32x4 acc[4][2];
#pragma unroll
      for (int mt = 0; mt < 4; ++mt)
#pragma unroll
          for (int nt = 0; nt < 2; ++nt) acc[mt][nt] = (f32x4){0.f, 0.f, 0.f, 0.f};
#pragma unroll
      for (int ks = 0; ks < 2; ++ks) { bf16x8 a[4];
#pragma unroll
          for (int mt = 0; mt < 4; ++mt) a[mt] = *(PG8_LAS const bf16x8*)(xcb + (mt * 16 + fr) * 72 + ks * 32 + fq * 8);
#pragma unroll
          for (int mt = 0; mt < 4; ++mt)
#pragma unroll
              for (int nt = 0; nt < 2; ++nt) acc[mt][nt] = __builtin_amdgcn_mfma_f32_16x16x32_bf16(W.wB[nt][ks], a[mt], acc[mt][nt], 0, 0, 0); }
      lds_f32p dstp = (kind ? LI : LA) + dirm * 4096;
#pragma unroll
      for (int nt = 0; nt < 2; ++nt) { const int col = nh * 32 + nt * 16 + fq * 4;
#pragma unroll
          for (int mt = 0; mt < 4; ++mt) { const int row = mt * 16 + fr; f32x4 v;
#pragma unroll
              for (int e = 0; e < 4; ++e) { const float sg = sigmoidf_(acc[mt][nt][e] + W.gb[nt][e]); v[e] = kind ? sg : -8.0f * sg * W.sp[nt][e]; }
              *(PG8_LAS f32x4*)(dstp + row * 64 + col) = v; } } }
    __syncthreads();
#pragma unroll
    for (int i = 0; i < 4; ++i) { const int vi = tid + 512 * i, dir = vi >> 10, jj = (vi >> 4) & 63, c4 = (vi & 15) * 4;
        const f32x4 la = *(PG8_LAS f32x4*)(LA + dir * 4096 + jj * 64 + c4), ig = *(PG8_LAS f32x4*)(LI + dir * 4096 + jj * 64 + c4), x = *(PG8_LAS f32x4*)(xc + jj * 64 + c4);
        f32x4 a, u;
#pragma unroll
        for (int e = 0; e < 4; ++e) { a[e] = fexp(la[e]);
            const float x2 = 2.0f * la[e]; const float om = x2 > -0.3f ? -x2 * (1.0f + x2 * (0.5f + x2 * (0.16666667f + x2 * (0.041666668f + x2 * 0.0083333338f)))) : 1.0f - a[e] * a[e];
            u[e] = __builtin_amdgcn_sqrtf(fmaxf(om, 0.f)) * ig[e] * x[e]; }
        *(PG8_LAS f32x4*)(LA + dir * 4096 + jj * 64 + c4) = a; *(PG8_LAS f32x4*)(LI + dir * 4096 + jj * 64 + c4) = u; }
    __syncthreads();
    { float a[16], u[16]; float hl = 0.f, Pl = 1.f;
#pragma unroll
      for (int e = 0; e < 16; ++e) { const int jj = seg * 16 + e, jr = sdir ? 63 - jj : jj; a[e] = LA[sdir * 4096 + jr * 64 + sch]; u[e] = LI[sdir * 4096 + jr * 64 + sch]; }
#pragma unroll
      for (int e = 0; e < 16; ++e) { hl = a[e] * hl + u[e]; Pl *= a[e]; }
      SEGP[seg * 128 + dc] = Pl; SEGH[seg * 128 + dc] = hl;
      __syncthreads();
      float H = carry, Pt = 1.f;
#pragma unroll
      for (int s = 0; s < 3; ++s) { const float ps = SEGP[s * 128 + dc], hs = SEGH[s * 128 + dc]; if (s < seg) { H = ps * H + hs; Pt *= ps; } }
      if (FINAL) {
#pragma unroll
          for (int e = 0; e < 16; ++e) { const int jj = seg * 16 + e, jr = sdir ? 63 - jj : jj; H = a[e] * H + u[e]; LI[sdir * 4096 + jr * 64 + sch] = H; }
      } else if (seg == 3) { RGA[so] = Pt * Pl; RGH[so] = Pl * H + hl; } }
    if (FINAL) {
        __syncthreads();
        float ga[8], o[8]; unpack8(garaw, ga);
#pragma unroll
        for (int e = 0; e < 8; ++e) o[e] = (LI[j * 64 + c8 + e] + LI[4096 + j * 64 + c8 + e]) * gelu_tanh(ga[e]);
        *(u32x4*)((bf16_t*)p.out + tok * 1024 + ch) = pack8(o);
    }
    __syncthreads();
}
__device__ void rg_carry(const Params& p) {
    float* RGA = (float*)(p.ws + WS_MISC + MO_RGA); float* RGH = (float*)(p.ws + WS_MISC + MO_RGH);
    const int idx = blockIdx.x * 512 + ltid();
    if (idx < 8192) { const int bd = idx >> 9, dir = bd & 1, ch = idx & 511; const size_t base = (size_t)bd * 64 * 512 + ch; float H = 0.f;
        for (int cb = 0; cb < 64; cb += 8) { float a[8], he[8];
#pragma unroll
            for (int e = 0; e < 8; ++e) { const int c = dir ? 63 - (cb + e) : cb + e; a[e] = RGA[base + c * 512]; he[e] = RGH[base + c * 512]; }
#pragma unroll
            for (int e = 0; e < 8; ++e) { const int c = dir ? 63 - (cb + e) : cb + e; RGH[base + c * 512] = H; H = a[e] * H + he[e]; } } }
}

constexpr int LDS_SEGT = 131072, LDS_RED = 133120;
__device__ __forceinline__ void hg_gate(const u32x4 raw, const float (&lb)[8], float (&lf)[8], float (&k)[8]) {
    float x[8]; unpack8(raw, x);
#pragma unroll
    for (int e = 0; e < 8; ++e) { const float ex = fexp(-x[e]), sg = frcp(1.0f + ex); lf[e] = flog(lb[e] + (1.0f - lb[e]) * sg); k[e] = (1.0f - lb[e]) * ex * sg; }
}
__device__ __forceinline__ void gla_gate(const bf16x8 wB, const bf16x8 (&lrA)[4], const f32x4 bias, lds_f32p cum, int wid, int fr, int fq) {
#pragma unroll
    for (int mt = 0; mt < 4; ++mt) { f32x4 z = __builtin_amdgcn_mfma_f32_16x16x32_bf16(wB, lrA[mt], (f32x4){0.f, 0.f, 0.f, 0.f}, 0, 0, 0);
#pragma unroll
        for (int e = 0; e < 4; ++e) { const float zz = z[e] + bias[e]; z[e] = (fminf(zz, 0.f) - flog(1.0f + fexp(-fabsf(zz)))) * (1.0f / 16.0f); }
        *(PG8_LAS f32x4*)(cum + (mt * 16 + fr) * 128 + wid * 16 + fq * 4) = z; }
}
__device__ __forceinline__ void chunk_scan(lds_f32p cum, lds_f32p segt, int dir, int tid) {
    const int seg = tid >> 7, d = tid & 127; float v[16], run = 0.f;
#pragma unroll
    for (int e = 0; e < 16; ++e) { const int jj = seg * 16 + e, j = dir ? 63 - jj : jj; v[e] = cum[j * 128 + d]; }
#pragma unroll
    for (int e = 0; e < 16; ++e) { run += v[e]; v[e] = run; }
    segt[seg * 128 + d] = run;
    __syncthreads();
    float off = 0.f;
#pragma unroll
    for (int s = 0; s < 3; ++s) { const float t = segt[s * 128 + d]; if (s < seg) off += t; }
#pragma unroll
    for (int e = 0; e < 16; ++e) { const int jj = seg * 16 + e, j = dir ? 63 - jj : jj; cum[j * 128 + d] = v[e] + off; }
}
typedef short s16x4 __attribute__((ext_vector_type(4)));
__device__ __forceinline__ bf16x8 frag_tr(PG8_LAS const bf16_t* img, int ld, int k0, int n0, int lane) {
    const int g = lane >> 4, q = (lane & 15) >> 2, pp = lane & 3;
    PG8_LAS const bf16_t* a0 = img + (k0 + 8 * g + q) * ld + n0 + 4 * pp;
    const s16x4 lo = __builtin_amdgcn_ds_read_tr16_b64_v4i16((PG8_LAS s16x4*)a0);
    const s16x4 hi = __builtin_amdgcn_ds_read_tr16_b64_v4i16((PG8_LAS s16x4*)(a0 + 4 * ld));
    return (bf16x8){lo[0], lo[1], lo[2], lo[3], hi[0], hi[1], hi[2], hi[3]};
}
__device__ __forceinline__ bf16x8 frag_tr_perm(PG8_LAS const bf16_t* img, int ld, int k0, int nb, int off, int lane) {
    const int g = lane >> 4, q = (lane & 15) >> 2, pp = lane & 3;
    PG8_LAS const bf16_t* a0 = img + (k0 + 8 * g + q) * ld + nb + 8 * pp + off;
    const s16x4 lo = __builtin_amdgcn_ds_read_tr16_b64_v4i16((PG8_LAS s16x4*)a0);
    const s16x4 hi = __builtin_amdgcn_ds_read_tr16_b64_v4i16((PG8_LAS s16x4*)(a0 + 4 * ld));
    return (bf16x8){lo[0], lo[1], lo[2], lo[3], hi[0], hi[1], hi[2], hi[3]};
}
template <int DV> __device__ __forceinline__ void store_v(const u32x4 (&vraw)[DV / 64], lds_bf16p V, int tid) {
    constexpr int G8 = DV / 8;
#pragma unroll
    for (int i = 0; i < DV / 64; ++i) { const int idx = tid + 512 * i, j = idx / G8, c8 = (idx % G8) * 8; *(PG8_LAS u32x4*)(V + j * (DV + 16) + c8) = vraw[i]; }
}
template <bool GLA> struct RawA { u32x4 v[GLA ? 4 : 2]; u32x4 k[GLA ? 2 : 4]; };
template <bool GLA> __device__ __forceinline__ void mix_a_load(const Params& p, int it, int half, RawA<GLA>& R) {
    constexpr int DV = GLA ? 256 : 128, G8 = DV / 8;
    const int c = it & 63, h = (it >> 6) & 3, bl = it >> 8, b = half * 4 + bl;
    const int tid = ltid(), lane = tid & 63, wid = tid >> 6, fr = lane & 15, fq = lane >> 4;
    const size_t tok0 = (size_t)b * SEQ + c * 64;
    const bf16_t* proj = (const bf16_t*)(p.ws + WS_A);
    const int d8 = (tid & 15) * 8, jb = tid >> 4;
#pragma unroll
    for (int i = 0; i < DV / 64; ++i) { const int idx = tid + 512 * i, j = idx / G8, c8 = (idx % G8) * 8;
        R.v[i] = *(const u32x4*)(GLA ? proj + (tok0 + j) * N_GLA + 1024 + h * 256 + c8 : proj + (tok0 + j) * N_AB + 2560 + h * 128 + c8); }
#pragma unroll
    for (int i = 0; i < 2; ++i) { const int j = jb + 32 * i;
        if (GLA) R.k[i] = *(const u32x4*)(proj + (tok0 + j) * N_GLA + 512 + h * 128 + d8);
        else { const bf16_t* rp = proj + (tok0 + j) * N_AB + 1536 + h * 128 + d8; R.k[i] = *(const u32x4*)rp; R.k[GLA ? 0 : 2 + i] = *(const u32x4*)(rp + 512); } }
}
template <bool GLA> __device__ __forceinline__ void mix_a_compute(const Params& p, PG8_LAS unsigned char* lds, int it, int half, const RawA<GLA>& R) {
    constexpr int DV = GLA ? 256 : 128;
    const int c = it & 63, h = (it >> 6) & 3, bl = it >> 8;
    const int tid = ltid(), lane = tid & 63, wid = tid >> 6, fr = lane & 15, fq = lane >> 4;
    lds_f32p cum = (lds_f32p)lds; lds_bf16p ksT = (lds_bf16p)(lds + 32768); lds_bf16p vT = (lds_bf16p)(lds + 51200); lds_f32p segt = (lds_f32p)(lds + LDS_SEGT);
    const int d8 = (tid & 15) * 8, jb = tid >> 4;
    bf16x8 lrA[4], wB[2]; f32x4 bias[2];
    if (GLA) { const bf16_t* proj = (const bf16_t*)(p.ws + WS_A); const size_t tok0 = (size_t)(half * 4 + bl) * SEQ + c * 64;
#pragma unroll
        for (int mt = 0; mt < 4; ++mt) lrA[mt] = *(const bf16x8*)(proj + (tok0 + mt * 16 + fr) * N_GLA + 3072 + fq * 8);
#pragma unroll
        for (int dir = 0; dir < 2; ++dir) { wB[dir] = (bf16x8){0, 0, 0, 0, 0, 0, 0, 0};
            if ((fq >> 1) == dir) wB[dir] = *(const bf16x8*)((const bf16_t*)(p.ws + WS_MISC + MO_WUPT) + (size_t)(dir * 512 + h * 128 + wid * 16 + fr) * 16 + (fq & 1) * 8);
            bias[dir] = *(const f32x4*)(p.in[20] + dir * 512 + h * 128 + wid * 16 + fq * 4); } }
    float lb[8];
    if (!GLA) { const float* lbv = (const float*)(p.ws + WS_MISC + MO_LBV) + h * 128 + d8; const f32x4 l0 = *(const f32x4*)lbv, l1 = *(const f32x4*)(lbv + 4);
#pragma unroll
        for (int e = 0; e < 4; ++e) { lb[e] = l0[e]; lb[4 + e] = l1[e]; } }
    store_v<DV>(R.v, vT, tid);
#pragma unroll
    for (int dir = 0; dir < 2; ++dir) {
        const int chain = ((half * 4 + bl) * 4 + h) * 2 + dir;
        bf16_t* st = (GLA ? gla_state(p, chain) : (bf16_t*)(p.ws + WS_ST) + (size_t)chain * 64 * DV * 128) + (size_t)c * DV * 128;
        float* decay = (float*)(p.ws + WS_MISC + MO_DECAY) + ((size_t)chain * 64 + c) * 128;
        float kk[2][8];
        if (GLA) {
            gla_gate(wB[dir], lrA, bias[dir], cum, wid, fr, fq);
#pragma unroll
            for (int i = 0; i < 2; ++i) unpack8(R.k[i], kk[i]);
        } else {
#pragma unroll
            for (int i = 0; i < 2; ++i) { const int j = jb + 32 * i; float lf[8]; hg_gate(R.k[GLA ? 0 : dir * 2 + i], lb, lf, kk[i]);
                *(PG8_LAS f32x4*)(cum + j * 128 + d8) = (f32x4){lf[0], lf[1], lf[2], lf[3]}; *(PG8_LAS f32x4*)(cum + j * 128 + d8 + 4) = (f32x4){lf[4], lf[5], lf[6], lf[7]}; }
        }
        __syncthreads();
        chunk_scan(cum, segt, dir, tid);
        __syncthreads();
        { const int lrow = dir ? 0 : 63;
          float last[8]; { const f32x4 l0 = *(PG8_LAS f32x4*)(cum + lrow * 128 + d8), l1 = *(PG8_LAS f32x4*)(cum + lrow * 128 + d8 + 4);
#pragma unroll
              for (int e = 0; e < 4; ++e) { last[e] = l0[e]; last[4 + e] = l1[e]; } }
#pragma unroll
          for (int i = 0; i < 2; ++i) { const int j = jb + 32 * i; const f32x4 c0 = *(PG8_LAS f32x4*)(cum + j * 128 + d8), c1 = *(PG8_LAS f32x4*)(cum + j * 128 + d8 + 4);
              float ks[8];
#pragma unroll
              for (int e = 0; e < 8; ++e) { const float cv = e < 4 ? c0[e] : c1[e - 4]; ks[e] = kk[i][e] * fexp(last[e] - cv); }
              *(PG8_LAS u32x4*)(ksT + j * 144 + d8) = pack8(ks); }
          if (tid < 128) decay[tid] = fexp(cum[lrow * 128 + tid]); }
        __syncthreads();
        { constexpr int MT = DV / 64; const int m0 = (wid >> 1) * (DV / 4), n0 = (wid & 1) * 64;
          f32x4 acc[MT][4];
#pragma unroll
          for (int mt = 0; mt < MT; ++mt)
#pragma unroll
              for (int nt = 0; nt < 4; ++nt) acc[mt][nt] = (f32x4){0.f, 0.f, 0.f, 0.f};
#pragma unroll
          for (int ks = 0; ks < 2; ++ks) { bf16x8 a[MT], bq[4];
#pragma unroll
              for (int mt = 0; mt < MT; ++mt) a[mt] = frag_tr((PG8_LAS const bf16_t*)vT, DV + 16, ks * 32, m0 + mt * 16, lane);
#pragma unroll
              for (int nt = 0; nt < 4; ++nt) bq[nt] = frag_tr_perm((PG8_LAS const bf16_t*)ksT, 144, ks * 32, n0 + (nt >> 1) * 32, (nt & 1) * 4, lane);
#pragma unroll
              for (int mt = 0; mt < MT; ++mt)
#pragma unroll
                  for (int nt = 0; nt < 4; ++nt) acc[mt][nt] = __builtin_amdgcn_mfma_f32_16x16x32_bf16(bq[nt], a[mt], acc[mt][nt], 0, 0, 0); }
#pragma unroll
          for (int mt = 0; mt < MT; ++mt)
#pragma unroll
              for (int k = 0; k < 2; ++k) { u32x4 pk; pk[0] = cvt_pk_bf16(acc[mt][2 * k][0], acc[mt][2 * k][1]); pk[1] = cvt_pk_bf16(acc[mt][2 * k][2], acc[mt][2 * k][3]);
                  pk[2] = cvt_pk_bf16(acc[mt][2 * k + 1][0], acc[mt][2 * k + 1][1]); pk[3] = cvt_pk_bf16(acc[mt][2 * k + 1][2], acc[mt][2 * k + 1][3]);
                  *(u32x4*)(st + (size_t)(m0 + mt * 16 + fr) * 128 + n0 + k * 32 + fq * 8) = pk; } }
    }
    __syncthreads();
}
template <int DV, bool GLA> __device__ void state_scan(const Params& p, const float* decay, int chain0, int nchains, PG8_LAS unsigned char* lds) {
    constexpr int ELEMS = DV * 128, SL = ELEMS / 4096;
    const int tid = ltid();
    lds_f32p dl = (lds_f32p)lds;
    for (int item = blockIdx.x; item < nchains * SL; item += gridDim.x) {
        const int cl = item / SL, chain = chain0 + cl, sl = item - cl * SL, dir = chain & 1, e0 = sl * 4096 + tid * 8, d8 = e0 & 127;
        bf16_t* sp = (GLA ? gla_state(p, chain) : (bf16_t*)(p.ws + WS_ST) + (size_t)chain * 64 * ELEMS) + e0; const float* dp = decay + (size_t)chain * 64 * 128;
#pragma unroll
        for (int i = 0; i < 4; ++i) *(PG8_LAS f32x4*)(dl + (tid + 512 * i) * 4) = *(const f32x4*)(dp + (tid + 512 * i) * 4);
        __syncthreads();
        float S[8];
#pragma unroll
        for (int e = 0; e < 8; ++e) S[e] = 0.f;
        for (int cb = 0; cb < 64; cb += 8) { u32x4 raw[8];
#pragma unroll
            for (int q = 0; q < 8; ++q) { const int c = dir ? 63 - (cb + q) : cb + q; raw[q] = *(const u32x4*)(sp + (size_t)c * ELEMS); }
#pragma unroll
            for (int q = 0; q < 8; ++q) { const int c = dir ? 63 - (cb + q) : cb + q; float u[8]; unpack8(raw[q], u);
                const f32x4 dc0 = *(PG8_LAS f32x4*)(dl + c * 128 + d8), dc1 = *(PG8_LAS f32x4*)(dl + c * 128 + d8 + 4);
                *(u32x4*)(sp + (size_t)c * ELEMS) = pack8(S);
#pragma unroll
                for (int e = 0; e < 8; ++e) S[e] = (e < 4 ? dc0[e] : dc1[e - 4]) * S[e] + u[e]; } }
        __syncthreads();
    }
}
template <bool GLA> struct RawC { u32x4 v[GLA ? 4 : 2]; u32x4 k[GLA ? 1 : 4]; };
template <bool GLA> __device__ __forceinline__ void mix_c_load(const Params& p, int it, int half, RawC<GLA>& R) {
    constexpr int DV = GLA ? 256 : 128, G8 = DV / 8;
    const int c = it & 63, h = (it >> 6) & 3, bl = it >> 8, b = half * 4 + bl;
    const int tid = ltid(), lane = tid & 63, wid = tid >> 6, fr = lane & 15, fq = lane >> 4;
    const size_t tok0 = (size_t)b * SEQ + c * 64;
    const bf16_t* proj = (const bf16_t*)(p.ws + WS_A);
    const int d8 = (tid & 15) * 8, jb = tid >> 4;
#pragma unroll
    for (int i = 0; i < DV / 64; ++i) { const int idx = tid + 512 * i, j = idx / G8, c8 = (idx % G8) * 8;
        R.v[i] = *(const u32x4*)(GLA ? proj + (tok0 + j) * N_GLA + 1024 + h * 256 + c8 : proj + (tok0 + j) * N_AB + 2560 + h * 128 + c8); }
#pragma unroll
    for (int i = 0; i < 2; ++i) { const int j = jb + 32 * i;
        if (!GLA) { const bf16_t* rp = proj + (tok0 + j) * N_AB + h * 128 + d8; R.k[i] = *(const u32x4*)(rp + 1536); R.k[GLA ? 0 : 2 + i] = *(const u32x4*)(rp + 2048); } }
}
template <bool GLA> __device__ __forceinline__ void mix_c_compute(const Params& p, PG8_LAS unsigned char* lds, int it, int half, const RawC<GLA>& R) {
    constexpr int DV = GLA ? 256 : 128, NT = DV / 128;
    const int c = it & 63, h = (it >> 6) & 3, bl = it >> 8, b = half * 4 + bl;
    const int tid = ltid(), lane = tid & 63, wid = tid >> 6, fr = lane & 15, fq = lane >> 4;
    lds_f32p cum = (lds_f32p)lds; lds_bf16p qin = (lds_bf16p)(lds + 32768); lds_bf16p kin = (lds_bf16p)(lds + 50176); lds_bf16p qc = (lds_bf16p)(lds + 67584);
    lds_bf16p P = (lds_bf16p)(lds + 84992); lds_bf16p vT = (lds_bf16p)(lds + 94208); lds_f32p segt = (lds_f32p)(lds + LDS_SEGT); lds_f32p red = (lds_f32p)(lds + LDS_RED);
    const size_t tok0 = (size_t)b * SEQ + c * 64;
    const bf16_t* proj = (const bf16_t*)(p.ws + WS_A);
    const int d8 = (tid & 15) * 8, jb = tid >> 4, n0 = wid * NT * 16;
    u32x4 qraw[2], kg[2];
#pragma unroll
    for (int i = 0; i < 2; ++i) { const int j = jb + 32 * i;
        if (GLA) { const bf16_t* rp = proj + (tok0 + j) * N_GLA + h * 128 + d8; qraw[i] = *(const u32x4*)rp; kg[i] = *(const u32x4*)(rp + 512); }
        else { qraw[i] = *(const u32x4*)(proj + (tok0 + j) * N_AB + 1024 + h * 128 + d8); kg[i] = qraw[i]; } }
    bf16x8 lrA[4], wB[2]; f32x4 gbias[2];
    if (GLA) {
#pragma unroll
        for (int mt = 0; mt < 4; ++mt) lrA[mt] = *(const bf16x8*)(proj + (tok0 + mt * 16 + fr) * N_GLA + 3072 + fq * 8);
#pragma unroll
        for (int dir = 0; dir < 2; ++dir) { wB[dir] = (bf16x8){0, 0, 0, 0, 0, 0, 0, 0};
            if ((fq >> 1) == dir) wB[dir] = *(const bf16x8*)((const bf16_t*)(p.ws + WS_MISC + MO_WUPT) + (size_t)(dir * 512 + h * 128 + wid * 16 + fr) * 16 + (fq & 1) * 8);
            gbias[dir] = *(const f32x4*)(p.in[20] + dir * 512 + h * 128 + wid * 16 + fq * 4); }
    }
    float lb[8];
    if (!GLA) { const float* lbv = (const float*)(p.ws + WS_MISC + MO_LBV) + h * 128 + d8; const f32x4 l0 = *(const f32x4*)lbv, l1 = *(const f32x4*)(lbv + 4);
#pragma unroll
        for (int e = 0; e < 4; ++e) { lb[e] = l0[e]; lb[4 + e] = l1[e]; } }
    store_v<DV>(R.v, vT, tid);
    f32x4 o[4][NT];
#pragma unroll
    for (int mt = 0; mt < 4; ++mt)
#pragma unroll
        for (int nt = 0; nt < NT; ++nt) o[mt][nt] = (f32x4){0.f, 0.f, 0.f, 0.f};
#pragma unroll
    for (int dir = 0; dir < 2; ++dir) {
        bf16x8 sB[NT][4];
        { const int chain = ((half * 4 + bl) * 4 + h) * 2 + dir;
          const bf16_t* st = (GLA ? gla_state(p, chain) : (bf16_t*)(p.ws + WS_ST) + (size_t)chain * 64 * DV * 128) + (size_t)c * DV * 128;
#pragma unroll
          for (int nt = 0; nt < NT; ++nt)
#pragma unroll
              for (int ks = 0; ks < 4; ++ks) sB[nt][ks] = *(const bf16x8*)(st + (size_t)(NT == 2 ? n0 + (fr >> 2) * 8 + nt * 4 + (fr & 3) : n0 + nt * 16 + fr) * 128 + ks * 32 + fq * 8); }
        float kk[2][8];
        if (GLA) { gla_gate(wB[dir], lrA, gbias[dir], cum, wid, fr, fq);
#pragma unroll
            for (int i = 0; i < 2; ++i) unpack8(kg[i], kk[i]);
        } else {
#pragma unroll
            for (int i = 0; i < 2; ++i) { const int j = jb + 32 * i; float lf[8]; hg_gate(R.k[GLA ? 0 : dir * 2 + i], lb, lf, kk[i]);
                *(PG8_LAS f32x4*)(cum + j * 128 + d8) = (f32x4){lf[0], lf[1], lf[2], lf[3]}; *(PG8_LAS f32x4*)(cum + j * 128 + d8 + 4) = (f32x4){lf[4], lf[5], lf[6], lf[7]}; }
        }
        __syncthreads();
        chunk_scan(cum, segt, dir, tid);
        __syncthreads();
        { const int jref = dir ? 31 : 32;
          float ref[8]; { const f32x4 l0 = *(PG8_LAS f32x4*)(cum + jref * 128 + d8), l1 = *(PG8_LAS f32x4*)(cum + jref * 128 + d8 + 4);
#pragma unroll
              for (int e = 0; e < 4; ++e) { ref[e] = l0[e]; ref[4 + e] = l1[e]; } }
#pragma unroll
          for (int i = 0; i < 2; ++i) { const int j = jb + 32 * i; const f32x4 c0 = *(PG8_LAS f32x4*)(cum + j * 128 + d8), c1 = *(PG8_LAS f32x4*)(cum + j * 128 + d8 + 4);
              float q[8], a[8], bb[8], cc[8]; unpack8(qraw[i], q);
#pragma unroll
              for (int e = 0; e < 8; ++e) { const float cv = e < 4 ? c0[e] : c1[e - 4];
                  const float qq = GLA ? q[e] * 0.08838834764831845f : q[e] * frcp(1.0f + fexp(-q[e]));
                  a[e] = qq * fexp(cv - ref[e]); bb[e] = kk[i][e] * fexp(ref[e] - cv); cc[e] = qq * fexp(cv); }
              *(PG8_LAS u32x4*)(qin + j * 136 + d8) = pack8(a); *(PG8_LAS u32x4*)(kin + j * 136 + d8) = pack8(bb); *(PG8_LAS u32x4*)(qc + j * 136 + d8) = pack8(cc); } }
        __syncthreads();
        { f32x4 s[1][2]; s[0][0] = (f32x4){0.f, 0.f, 0.f, 0.f}; s[0][1] = s[0][0];
          const int m0 = (wid & 3) * 16, l = m0 + fr, sn0 = (wid >> 2) * 32;
          mma_tiles<1, 2, false, false, 128>(s, (PG8_LAS const bf16_t*)qin, 136, m0, (PG8_LAS const bf16_t*)kin, 136, sn0, fr, fq);
#pragma unroll
          for (int nt = 0; nt < 2; ++nt) { const int mc = sn0 + nt * 16 + fq * 4; float v[4];
#pragma unroll
              for (int e = 0; e < 4; ++e) { const bool keep = dir ? (l <= mc + e) : (l >= mc + e); v[e] = keep ? s[0][nt][e] : 0.f; }
              u32x2 pk; pk[0] = cvt_pk_bf16(v[0], v[1]); pk[1] = cvt_pk_bf16(v[2], v[3]); *(PG8_LAS u32x2*)(P + l * 72 + mc) = pk; } }
        __syncthreads();
#pragma unroll
        for (int ks = 0; ks < 2; ++ks) { bf16x8 a[4], bq[NT];
#pragma unroll
            for (int mt = 0; mt < 4; ++mt) a[mt] = *(PG8_LAS const bf16x8*)(P + (mt * 16 + fr) * 72 + ks * 32 + fq * 8);
#pragma unroll
            for (int nt = 0; nt < NT; ++nt) bq[nt] = NT == 2 ? frag_tr_perm((PG8_LAS const bf16_t*)vT, DV + 16, ks * 32, n0, nt * 4, lane) : frag_tr((PG8_LAS const bf16_t*)vT, DV + 16, ks * 32, n0 + nt * 16, lane);
#pragma unroll
            for (int mt = 0; mt < 4; ++mt)
#pragma unroll
                for (int nt = 0; nt < NT; ++nt) o[mt][nt] = __builtin_amdgcn_mfma_f32_16x16x32_bf16(bq[nt], a[mt], o[mt][nt], 0, 0, 0); }
#pragma unroll
        for (int ks = 0; ks < 4; ++ks) { bf16x8 a[4];
#pragma unroll
            for (int mt = 0; mt < 4; ++mt) a[mt] = *(PG8_LAS const bf16x8*)(qc + (mt * 16 + fr) * 136 + ks * 32 + fq * 8);
#pragma unroll
            for (int mt = 0; mt < 4; ++mt)
#pragma unroll
                for (int nt = 0; nt < NT; ++nt) o[mt][nt] = __builtin_amdgcn_mfma_f32_16x16x32_bf16(sB[nt][ks], a[mt], o[mt][nt], 0, 0, 0);
            if (ks & 1) __builtin_amdgcn_sched_barrier(0); }
        __builtin_amdgcn_sched_barrier(0);
    }
    const float* gain = (GLA ? p.in[21] : p.in[16]) + h * DV;
    u32x2 graw[4][NT];
#pragma unroll
    for (int mt = 0; mt < 4; ++mt)
#pragma unroll
        for (int nt = 0; nt < NT; ++nt) { const size_t tok = tok0 + mt * 16 + fr; const int col = NT == 2 ? n0 + fq * 8 + nt * 4 : n0 + nt * 16 + fq * 4;
            graw[mt][nt] = *(const u32x2*)(GLA ? proj + tok * N_GLA + 2048 + h * 256 + col : proj + tok * N_AB + 3072 + h * 128 + col); }
#pragma unroll
    for (int mt = 0; mt < 4; ++mt) { float ss = 0.f;
#pragma unroll
        for (int nt = 0; nt < NT; ++nt)
#pragma unroll
            for (int e = 0; e < 4; ++e) ss += o[mt][nt][e] * o[mt][nt][e];
        ss += __shfl_xor(ss, 16); ss += __shfl_xor(ss, 32);
        if (fq == 0) red[wid * 64 + mt * 16 + fr] = ss; }
    __syncthreads();
#pragma unroll
    for (int mt = 0; mt < 4; ++mt) { const int row = mt * 16 + fr; float tot = 0.f;
#pragma unroll
        for (int w = 0; w < 8; ++w) tot += red[w * 64 + row];
        const float rstd = rsqrtf(tot * (1.0f / DV) + EPS);
        bf16_t* outp = (bf16_t*)p.out + (tok0 + row) * 1024 + (GLA ? 0 : 512) + h * DV;
        unsigned pkw[2 * NT];
#pragma unroll
        for (int nt = 0; nt < NT; ++nt) { const int col = NT == 2 ? n0 + fq * 8 + nt * 4 : n0 + nt * 16 + fq * 4; const f32x4 gn = *(const f32x4*)(gain + col); float y[4];
#pragma unroll
            for (int e = 0; e < 4; ++e) { const unsigned wv = graw[mt][nt][e >> 1]; const float gv = __uint_as_float((e & 1) ? (wv & 0xffff0000u) : (wv << 16));
                y[e] = o[mt][nt][e] * rstd * gn[e] * (gv * frcp(1.0f + fexp(-gv))); }
            pkw[2 * nt] = cvt_pk_bf16(y[0], y[1]); pkw[2 * nt + 1] = cvt_pk_bf16(y[2], y[3]); }
        if (NT == 2) { u32x4 pk; pk[0] = pkw[0]; pk[1] = pkw[1]; pk[2] = pkw[2 * NT - 2]; pk[3] = pkw[2 * NT - 1]; *(u32x4*)(outp + n0 + fq * 8) = pk; }
        else { u32x2 pk; pk[0] = pkw[0]; pk[1] = pkw[1]; *(u32x2*)(outp + n0 + fq * 4) = pk; } }
    __syncthreads();
}

template <bool GLA> __device__ __forceinline__ void mix_a_phase(const Params& p, PG8_LAS unsigned char* lds, int nitems, int half) {
    RawA<GLA> A{}, B{}; int it = blockIdx.x; const int G = gridDim.x; if (it < nitems) mix_a_load<GLA>(p, it, half, A);
    while (it < nitems) {
        if (it + G < nitems) mix_a_load<GLA>(p, it + G, half, B);
        mix_a_compute<GLA>(p, lds, it, half, A); it += G; if (it >= nitems) break;
        if (it + G < nitems) mix_a_load<GLA>(p, it + G, half, A);
        mix_a_compute<GLA>(p, lds, it, half, B); it += G; }
}
template <bool GLA> __device__ __forceinline__ void mix_c_phase(const Params& p, PG8_LAS unsigned char* lds, int nitems, int half) {
    RawC<GLA> A{}, B{}; int it = blockIdx.x; const int G = gridDim.x; if (it < nitems) mix_c_load<GLA>(p, it, half, A);
    while (it < nitems) {
        if (it + G < nitems) mix_c_load<GLA>(p, it + G, half, B);
        mix_c_compute<GLA>(p, lds, it, half, A); it += G; if (it >= nitems) break;
        if (it + G < nitems) mix_c_load<GLA>(p, it + G, half, A);
        mix_c_compute<GLA>(p, lds, it, half, B); it += G; }
}
template <bool FINAL> __device__ __forceinline__ void rg_phase(const Params& p, PG8_LAS unsigned char* lds) {
    RawR<FINAL> A{}, B{}; RgW W{}; int it = blockIdx.x; const int G = gridDim.x; const bool gconst = (G & 7) == 0;
    if (it < 4096) { rg_load_w(p, it & 7, W); rg_load<FINAL>(p, it, A); }
    while (it < 4096) {
        if (it + G < 4096) rg_load<FINAL>(p, it + G, B);
        if (!gconst) rg_load_w(p, it & 7, W);
        rg_compute<FINAL>(p, lds, it, A, W); it += G; if (it >= 4096) break;
        if (it + G < 4096) rg_load<FINAL>(p, it + G, A);
        if (!gconst) rg_load_w(p, it & 7, W);
        rg_compute<FINAL>(p, lds, it, B, W); it += G; }
}
#define XB_TMO      128
#define XB_XCNT(j)  (256  + 64 * (j))
#define XB_XSUB(j)  (1280 + 64 * (j))
#define XB_XGEN(j)  (2304 + 64 * (j))
#define XB_TOP      3328
#define XB_TOPGEN   3392
#define XCD_BAR_WORDS 3456
#define XB_SPIN_CAP (1u << 18)
#define LAS __attribute__((address_space(3)))

__device__ __forceinline__ unsigned xb_ld(unsigned* p)              { return __hip_atomic_load(p, __ATOMIC_RELAXED, __HIP_MEMORY_SCOPE_AGENT); }
__device__ __forceinline__ unsigned xb_add(unsigned* p, unsigned v) { return __hip_atomic_fetch_add(p, v, __ATOMIC_RELAXED, __HIP_MEMORY_SCOPE_AGENT); }
__device__ __forceinline__ unsigned xb_xcc_id() { return (unsigned)__builtin_amdgcn_s_getreg((3 << 11) | 20) & 0xFu; }
#define XB_SPIN(cond, bar) do { unsigned _sp = 0; while (cond) { __builtin_amdgcn_s_sleep(1); \
    if ((++_sp & 255u) == 0u) { if (xb_ld(&(bar)[XB_TMO])) break; if (_sp > XB_SPIN_CAP) { atomicAdd(&(bar)[XB_TMO], 1u); break; } } } } while (0)

struct XcdBarrier {
    unsigned* bar; unsigned x;
    volatile LAS unsigned* st;
};

__device__ __forceinline__ XcdBarrier xcd_barrier_post(unsigned* bar, volatile LAS unsigned* st) {
    XcdBarrier b; b.bar = bar; b.x = xb_xcc_id(); b.st = st;
    if (threadIdx.x == 0) (void)xb_add(&bar[XB_XCNT(b.x)], 1u);
    return b;
}
__device__ __forceinline__ void xcd_barrier_complete(unsigned* bar, unsigned x, unsigned& nloc, unsigned& nx) {
    const unsigned G = gridDim.x * gridDim.y * gridDim.z;
    unsigned sum, cnt, mine, sp = 0u;
    for (;;) {
        sum = 0u; cnt = 0u; mine = 0u;
#pragma unroll
        for (unsigned j = 0; j < 16; ++j) { const unsigned c = xb_ld(&bar[XB_XCNT(j)]); sum += c; cnt += (c > 0u) ? 1u : 0u; mine = (j == x) ? c : mine; }
        if (sum == G) break;
        __builtin_amdgcn_s_sleep(1);
        if ((++sp & 255u) == 0u) { if (xb_ld(&bar[XB_TMO])) break; if (sp > XB_SPIN_CAP) { atomicAdd(&bar[XB_TMO], 1u); break; } }
    }
    nloc = mine > 0u ? mine : 1u; nx = cnt > 0u ? cnt : 1u;
}

__device__ __forceinline__ void xcd_barrier(const XcdBarrier& b) {
    asm volatile("s_waitcnt vmcnt(0)" ::: "memory");
    __syncthreads();
    if (threadIdx.x == 0) {
        unsigned* bar = b.bar;
        __builtin_amdgcn_s_waitcnt(0);
        unsigned nloc = b.st[0], nx = b.st[1];
        if (nloc == 0u) { xcd_barrier_complete(bar, b.x, nloc, nx); b.st[0] = nloc; b.st[1] = nx; }
        const unsigned old = xb_add(&bar[XB_XSUB(b.x)], 1u);
        const unsigned gen = old / nloc;
        if (old + 1u == (gen + 1u) * nloc) {
            __builtin_amdgcn_fence(__ATOMIC_RELEASE, "agent");
            asm volatile("s_waitcnt vmcnt(0)" ::: "memory");
            const unsigned og = xb_add(&bar[XB_TOP], 1u);
            const unsigned tg = og / nx;
            if (og + 1u == (tg + 1u) * nx) xb_add(&bar[XB_TOPGEN], 1u);
            else XB_SPIN(xb_ld(&bar[XB_TOPGEN]) == tg, bar);
            __builtin_amdgcn_fence(__ATOMIC_ACQUIRE, "agent");
            xb_add(&bar[XB_XGEN(b.x)], 1u);
            asm volatile("s_waitcnt vmcnt(0)" ::: "memory");
        } else {
            XB_SPIN(xb_ld(&bar[XB_XGEN(b.x)]) == gen, bar);
            __builtin_amdgcn_fence(__ATOMIC_ACQUIRE, "agent");
            asm volatile("s_waitcnt vmcnt(0)" ::: "memory");
        }
    }
    __syncthreads();
}

constexpr int NPHASE = 19;
constexpr int LDS_BAR = 135168, LDS_BYTES = 135184;
__device__ __forceinline__ void run_phase(const Params& p, PG8_LAS unsigned char* lds, int ph) {
    bf16_t* W = (bf16_t*)(p.ws + WS_W);
    u64* sumsq = (u64*)(p.ws + WS_SS);
    bf16_t* R1 = (bf16_t*)(p.ws + WS_R1); bf16_t* RA = (bf16_t*)(p.ws + WS_A); bf16_t* OB = (bf16_t*)p.out;
    switch (ph) {
    case 0: phase_prep(p, lds); break;
    case 1: case 8: { EpiScale<0> E; E.O = RA; E.ldc = ph == 1 ? N_AB : N_GLA; E.sumsq = sumsq + (ph == 1 ? 0 : 2 * MTOK);
        if (ph == 1 && (blockIdx.x & 1) == 0) convert_tiles(p, lds, 896, 6336);
        run_gemm(lds, R1, W + (ph == 1 ? WO_ABIN : WO_GLAIN), ph == 1 ? N_AB : N_GLA, 1024, E);
        if (ph == 1 && (blockIdx.x & 1) != 0) convert_tiles(p, lds, 896, 6336); } break;
    case 2: for (int pass = 0; pass < 2; ++pass) { if (((pass ^ (int)blockIdx.x) & 1) == 0) mix_a_phase<false>(p, lds, 2048, 0); else rg_phase<false>(p, lds); } break;
    case 3: state_scan<128, false>(p, (const float*)(p.ws + WS_MISC + MO_DECAY), 0, 64, lds); rg_carry(p); break;
    case 4: for (int pass = 0; pass < 2; ++pass) { if (((pass ^ (int)blockIdx.x) & 1) == 0) mix_c_phase<false>(p, lds, 2048, 0); else rg_phase<true>(p, lds); } break;
    case 5: { EpiResid<true> E; E.Xin = p.in[0]; E.H = R1; E.sumsq = sumsq + 1 * MTOK; run_gemm(lds, OB, W + WO_ABOUT, 1024, 1024, E); } break;
    case 7: case 15: case 17: { EpiResid<false> E; E.Xin = nullptr; E.H = R1; E.sumsq = sumsq + (ph == 7 ? 2 : ph == 15 ? 3 : 4) * MTOK;
        run_gemm(lds, ph == 15 ? OB : RA, W + (ph == 7 ? WO_W2_0 : ph == 15 ? WO_GLAOUT : WO_W2_1), 1024, ph == 15 ? 1024 : 4096, E); } break;
    case 6: case 16: { EpiScale<1> E; E.O = RA; E.ldc = DFF; E.sumsq = sumsq + (ph == 6 ? 1 : 3) * MTOK;
        run_gemm(lds, R1, W + (ph == 6 ? WO_W1_0 : WO_W1_1), DFF, 1024, E); } break;
    case 9: mix_a_phase<true>(p, lds, 1024, 0); break;
    case 10: for (int pass = 0; pass < 2; ++pass) { if (((pass ^ (int)blockIdx.x) & 1) == 0) state_scan<256, true>(p, (const float*)(p.ws + WS_MISC + MO_DECAY), 0, 32, lds); else mix_a_phase<true>(p, lds, 1024, 1); } break;
    case 11: for (int pass = 0; pass < 2; ++pass) { if (((pass ^ (int)blockIdx.x) & 1) == 0) mix_c_phase<true>(p, lds, 1024, 0); else state_scan<256, true>(p, (const float*)(p.ws + WS_MISC + MO_DECAY), 32, 32, lds); } break;
    case 12: mix_c_phase<true>(p, lds, 1024, 1); break;
    case 18: phase_final(p); break;
    }
}
#if MULTI
template <int PH> __global__ void __launch_bounds__(512, 2) k_phase(Params p) {
    extern __shared__ __attribute__((aligned(16))) unsigned char shm[];
    run_phase(p, (PG8_LAS unsigned char*)shm, PH);
}
#else
__global__ void __launch_bounds__(512, 2) k_mega(Params p) {
    extern __shared__ __attribute__((aligned(16))) unsigned char shm[];
    cg::grid_group grid = cg::this_grid();
#ifdef ONLY_PH
    run_phase(p, (PG8_LAS unsigned char*)shm, ONLY_PH);
#else
#define PH_(n) { const Params q = load_params(); run_phase(q, (PG8_LAS unsigned char*)shm, n); \
        XcdBarrier xb; xb.bar = (unsigned*)(q.ws + WS_MISC + MO_BAR); xb.x = xb_xcc_id(); xb.st = st; xcd_barrier(xb); }
    volatile LAS unsigned* st = (volatile LAS unsigned*)((PG8_LAS unsigned char*)shm + LDS_BAR);
    if (threadIdx.x == 0) { st[0] = 0u; st[1] = 0u; }
    __syncthreads();
    { const Params q = load_params();
      if (q.ws == nullptr) grid.sync();
      (void)xcd_barrier_post((unsigned*)(q.ws + WS_MISC + MO_BAR), st); }
    PH_(0) PH_(1) PH_(2) PH_(3) PH_(4) PH_(5) PH_(6) PH_(7) PH_(8) PH_(9) PH_(10) PH_(11) PH_(12) PH_(15) PH_(16) PH_(17)
    { const Params q = load_params(); run_phase(q, (PG8_LAS unsigned char*)shm, 18); }
#endif
}
#endif

extern "C" void kernel_launch(void* const* d_in, const int* in_sizes, int n_in, void* d_out, int out_size, void* d_ws, size_t ws_size, hipStream_t stream) {
    static int grid = 0;
    if (grid == 0) {
        if (n_in != 22 || ws_size < WS_END) { fprintf(stderr, "kernel_launch: unexpected n_in %d / ws_size %zu (need %zu)\n", n_in, ws_size, (size_t)WS_END); }
        int dev = 0, cus = 0, per_cu = 0;
        hipGetDevice(&dev); hipDeviceGetAttribute(&cus, hipDeviceAttributeMultiprocessorCount, dev);
#if MULTI
#define SA_(n) hipFuncSetAttribute((const void*)k_phase<n>, hipFuncAttributeMaxDynamicSharedMemorySize, LDS_BYTES);
        SA_(0) SA_(1) SA_(2) SA_(3) SA_(4) SA_(5) SA_(6) SA_(7) SA_(8) SA_(9) SA_(10) SA_(11) SA_(12) SA_(13) SA_(14) SA_(15) SA_(16) SA_(17) SA_(18)
        per_cu = 1;
#else
        hipFuncSetAttribute((const void*)k_mega, hipFuncAttributeMaxDynamicSharedMemorySize, LDS_BYTES);
        hipOccupancyMaxActiveBlocksPerMultiprocessor(&per_cu, (const void*)k_mega, 512, LDS_BYTES);
#endif
        if (per_cu < 1) { fprintf(stderr, "kernel_launch: occupancy query says %d blocks per CU\n", per_cu); per_cu = 1; }
        if (per_cu > 1) per_cu = 1;
        grid = cus * per_cu;
    }
    Params p{};
    for (int i = 0; i < 22; ++i) p.in[i] = (const float*)d_in[i];
    p.out = (float*)d_out; p.ws = (unsigned char*)d_ws;
#if MULTI
#define LP_(n) k_phase<n><<<dim3(grid), dim3(512), LDS_BYTES, stream>>>(p);
    LP_(0) LP_(1) LP_(2) LP_(3) LP_(4) LP_(5) LP_(6) LP_(7) LP_(8) LP_(9) LP_(10) LP_(11) LP_(12) LP_(13) LP_(14) LP_(15) LP_(16) LP_(17) LP_(18)
#else
    (void)hipMemsetAsync((unsigned char*)d_ws + WS_MISC + MO_BAR, 0, XCD_BAR_WORDS * sizeof(unsigned), stream);
    void* args[] = {&p};
    hipError_t e = hipLaunchCooperativeKernel((const void*)k_mega, dim3(grid), dim3(512), args, LDS_BYTES, stream);
    if (e != hipSuccess) fprintf(stderr, "cooperative launch failed: %s (grid %d)\n", hipGetErrorString(e), grid);
#endif
}
```
